# Optimizing an MI355X kernel written in HIP

```python
import math
import jax
import jax.numpy as jnp
from jax import lax
import numpy as np

D_MODEL = 1024
BATCH = 2
SEQ = 8192
DEPTH = 2

N_HEADS = 8
HEAD_DIM = 64
ATTN_WIDTH = N_HEADS * HEAD_DIM
MOBA_BLOCK = 256
MOBA_TOPK = 3
QUERY_CHUNK = 64
ROPE_THETA = 10000.0
S5_GROUP = 16
S5_GROUPS = 32
S5_WIDTH = S5_GROUP * S5_GROUPS
S5_STATE = 64
DT_MIN = 0.001
DT_MAX = 0.1
IN_COLS = 3 * ATTN_WIDTH + S5_WIDTH + 2 * D_MODEL
N_EXPERTS = 256
TOP_K = 8
N_EXPERT_GROUPS = 8
TOPK_GROUPS = 4
EXPERT_HIDDEN = 256
SHARED_HIDDEN = 256
ROUTED_SCALE = 2.5
MOE_ROW_BLOCK = 64
DN_ALPHA = (2 * DEPTH) ** 0.25
DN_BETA = (8 * DEPTH) ** -0.25
LN_EPS = 1e-5
NEG_INF = -1e30

kernel_name = 'hybrid_moba_s5_moe_deepnorm'


def layer_norm(x, g, b):
    xf = x.astype(jnp.float32)
    mu = jnp.mean(xf, axis=-1, keepdims=True)
    xc = xf - mu
    var = jnp.mean(xc * xc, axis=-1, keepdims=True)
    return (xc * lax.rsqrt(var + LN_EPS) * g.astype(jnp.float32) + b.astype(jnp.float32)).astype(x.dtype)


def rope_tables(positions):
    inv_freq = ROPE_THETA ** (-jnp.arange(0, HEAD_DIM, 2, dtype=jnp.float32) / HEAD_DIM)
    ang = positions.astype(jnp.float32)[..., None] * inv_freq
    return jnp.cos(ang)[:, :, None, :], jnp.sin(ang)[:, :, None, :]


def apply_rope(t, cos, sin):
    half = t.shape[-1] // 2
    t1 = t[..., :half].astype(jnp.float32)
    t2 = t[..., half:].astype(jnp.float32)
    return jnp.concatenate([t1 * cos - t2 * sin, t2 * cos + t1 * sin], axis=-1).astype(t.dtype)


def moba_attention(q, k, v):
    bsz, seq, n_heads, hd = q.shape
    n_blocks = -(-seq // MOBA_BLOCK)
    pad = n_blocks * MOBA_BLOCK - seq
    qh = q.transpose(0, 2, 1, 3)
    kh = jnp.pad(k.transpose(0, 2, 1, 3), ((0, 0), (0, 0), (0, pad), (0, 0)))
    vh = jnp.pad(v.transpose(0, 2, 1, 3), ((0, 0), (0, 0), (0, pad), (0, 0)))
    kb = kh.reshape(bsz, n_heads, n_blocks, MOBA_BLOCK, hd)
    vb = vh.reshape(bsz, n_heads, n_blocks, MOBA_BLOCK, hd)
    k_mean = jnp.mean(kb.astype(jnp.float32), axis=3)
    n_sel = min(MOBA_TOPK, n_blocks)
    scale = hd ** -0.5
    b_ix = jnp.arange(bsz)[:, None, None, None]
    h_ix = jnp.arange(n_heads)[None, :, None, None]
    blk_ids = jnp.arange(n_blocks)

    def chunk(c):
        q0 = c * QUERY_CHUNK
        qblk = q0 // MOBA_BLOCK
        qc = lax.dynamic_slice_in_dim(qh, q0, QUERY_CHUNK, axis=2).astype(jnp.float32)
        gate = jnp.einsum('bhqd,bhnd->bhqn', qc, k_mean)
        gate = jnp.where(blk_ids < qblk, gate, NEG_INF)
        _, sel = lax.top_k(gate, n_sel)
        sel_valid = sel < qblk
        kg = kb[b_ix, h_ix, sel].astype(jnp.float32)
        vg = vb[b_ix, h_ix, sel].astype(jnp.float32)
        s_sel = jnp.einsum('bhqd,bhqjtd->bhqjt', qc, kg) * scale
        s_sel = jnp.where(sel_valid[..., None], s_sel, NEG_INF)
        s_sel = s_sel.reshape(bsz, n_heads, QUERY_CHUNK, n_sel * MOBA_BLOCK)
        k_own = lax.dynamic_slice_in_dim(kh, qblk * MOBA_BLOCK, MOBA_BLOCK, axis=2).astype(jnp.float32)
        v_own = lax.dynamic_slice_in_dim(vh, qblk * MOBA_BLOCK, MOBA_BLOCK, axis=2).astype(jnp.float32)
        s_own = jnp.einsum('bhqd,bhtd->bhqt', qc, k_own) * scale
        q_pos = q0 + jnp.arange(QUERY_CHUNK)
        k_pos = qblk * MOBA_BLOCK + jnp.arange(MOBA_BLOCK)
        s_own = jnp.where(k_pos[None, :] <= q_pos[:, None], s_own, NEG_INF)
        p = jax.nn.softmax(jnp.concatenate([s_sel, s_own], axis=-1), axis=-1)
        p_sel = p[..., :n_sel * MOBA_BLOCK].reshape(bsz, n_heads, QUERY_CHUNK, n_sel, MOBA_BLOCK)
        p_own = p[..., n_sel * MOBA_BLOCK:]
        o = jnp.einsum('bhqjt,bhqjtd->bhqd', p_sel, vg) + jnp.einsum('bhqt,bhtd->bhqd', p_own, v_own)
        return o.astype(q.dtype)

    out = lax.map(chunk, jnp.arange(seq // QUERY_CHUNK))
    return out.transpose(1, 0, 3, 2, 4).reshape(bsz, seq, n_heads * hd)


def s5_branch(u, lam_re, lam_im, log_dt, b_re, b_im, c_re, c_im, d_skip, w_glu, b_glu):
    bsz, seq, width = u.shape
    uf = u.astype(jnp.float32)
    ug = uf.reshape(bsz, seq, S5_GROUPS, S5_GROUP)
    lr = lam_re.astype(jnp.float32)
    li = lam_im.astype(jnp.float32)
    dt = jnp.exp(log_dt.astype(jnp.float32))[:, None]
    mag = jnp.exp(lr * dt)
    a_re = mag * jnp.cos(li * dt)
    a_im = mag * jnp.sin(li * dt)
    den = lr * lr + li * li
    nr = a_re - 1.0
    coef_re = (nr * lr + a_im * li) / den
    coef_im = (a_im * lr - nr * li) / den
    br = b_re.astype(jnp.float32)
    bi = b_im.astype(jnp.float32)
    bbar_re = coef_re[..., None] * br - coef_im[..., None] * bi
    bbar_im = coef_re[..., None] * bi + coef_im[..., None] * br
    bu_re = jnp.einsum('bsgc,gnc->bsgn', ug, bbar_re)
    bu_im = jnp.einsum('bsgc,gnc->bsgn', ug, bbar_im)
    at_re = jnp.broadcast_to(a_re, bu_re.shape)
    at_im = jnp.broadcast_to(a_im, bu_im.shape)

    def combine(e1, e2):
        a1r, a1i, b1r, b1i = e1
        a2r, a2i, b2r, b2i = e2
        return (a2r * a1r - a2i * a1i,
                a2r * a1i + a2i * a1r,
                a2r * b1r - a2i * b1i + b2r,
                a2r * b1i + a2i * b1r + b2i)

    _, _, h_re, h_im = lax.associative_scan(combine, (at_re, at_im, bu_re, bu_im), axis=1)
    y = (jnp.einsum('bsgn,gcn->bsgc', h_re, c_re.astype(jnp.float32))
         - jnp.einsum('bsgn,gcn->bsgc', h_im, c_im.astype(jnp.float32)))
    y = y.reshape(bsz, seq, width) + d_skip.astype(jnp.float32) * uf
    z = jax.nn.gelu(y)
    out = z * jax.nn.sigmoid(z @ w_glu.astype(jnp.float32) + b_glu.astype(jnp.float32))
    return out.astype(u.dtype)


def routed_experts(xt, top_idx, gate_w, w_gate_e, w_up_e, w_down_e):
    n_tok, d = xt.shape
    n_exp = w_gate_e.shape[0]
    m = MOE_ROW_BLOCK
    n_assign = n_tok * TOP_K
    flat_e = top_idx.reshape(n_assign)
    flat_tok = jnp.repeat(jnp.arange(n_tok, dtype=jnp.int32), TOP_K)
    flat_w = gate_w.reshape(n_assign)
    order = jnp.argsort(flat_e)
    e_s = flat_e[order]
    tok_s = flat_tok[order]
    w_s = flat_w[order]
    counts = jnp.bincount(flat_e, length=n_exp)
    starts = jnp.cumsum(counts) - counts
    padded = (counts + m - 1) // m * m
    padded_ends = jnp.cumsum(padded)
    padded_starts = padded_ends - padded
    dest = padded_starts[e_s] + jnp.arange(n_assign) - starts[e_s]
    n_row_blocks = -(-(n_assign + n_exp * (m - 1)) // m)
    n_rows = n_row_blocks * m
    row_tok = jnp.full((n_rows,), n_tok, jnp.int32).at[dest].set(tok_s)
    row_w = jnp.zeros((n_rows,), jnp.float32).at[dest].set(w_s)
    block_e = jnp.minimum(jnp.searchsorted(padded_ends, jnp.arange(n_row_blocks) * m, side='right'), n_exp - 1)
    x_pad = jnp.concatenate([xt, jnp.zeros((1, d), xt.dtype)], axis=0)

    def block(args):
        e, toks, wts = args
        xb = x_pad[toks]
        h = jax.nn.silu(xb @ w_gate_e[e]) * (xb @ w_up_e[e])
        return (h @ w_down_e[e]) * wts[:, None]

    y = lax.map(block, (block_e, row_tok.reshape(n_row_blocks, m), row_w.reshape(n_row_blocks, m)))
    return jax.ops.segment_sum(y.reshape(n_rows, d), row_tok, num_segments=n_tok + 1)[:n_tok]


def moe_ffn(x, w_router, router_bias, w_gate_e, w_up_e, w_down_e, ws_gate, ws_up, ws_down):
    bsz, seq, d = x.shape
    n_tok = bsz * seq
    xt = x.reshape(n_tok, d)
    scores = jax.nn.sigmoid(xt.astype(jnp.float32) @ w_router.astype(jnp.float32))
    biased = scores + router_bias.astype(jnp.float32)
    per_group = N_EXPERTS // N_EXPERT_GROUPS
    group_score = lax.top_k(biased.reshape(n_tok, N_EXPERT_GROUPS, per_group), 2)[0].sum(-1)
    _, top_groups = lax.top_k(group_score, TOPK_GROUPS)
    group_mask = jax.nn.one_hot(top_groups, N_EXPERT_GROUPS, dtype=jnp.float32).sum(-2) > 0
    expert_mask = jnp.repeat(group_mask, per_group, axis=-1)
    _, top_idx = lax.top_k(jnp.where(expert_mask, biased, NEG_INF), TOP_K)
    w = jnp.take_along_axis(scores, top_idx, axis=-1)
    w = w / jnp.sum(w, axis=-1, keepdims=True) * ROUTED_SCALE
    routed = routed_experts(xt, top_idx, w, w_gate_e, w_up_e, w_down_e)
    shared = (jax.nn.silu(xt @ ws_gate) * (xt @ ws_up)) @ ws_down
    return (routed + shared).astype(x.dtype).reshape(bsz, seq, d)


def setup_inputs(seed: int = 0) -> dict:
    key = jax.random.key(seed)
    ks = jax.random.split(key, 32)
    f32 = jnp.float32

    def nrm(k, shape, fan_in, scale=1.0):
        return jax.random.normal(k, shape, f32) * (scale * fan_in ** -0.5)

    x = jax.random.normal(ks[0], (BATCH, SEQ, D_MODEL), f32)
    positions = jnp.broadcast_to(jnp.arange(SEQ, dtype=jnp.int32), (BATCH, SEQ))
    w_in = nrm(ks[1], (DEPTH, D_MODEL, IN_COLS), D_MODEL)
    attn_up = nrm(ks[2], (DEPTH, ATTN_WIDTH, D_MODEL), ATTN_WIDTH)
    lam_re = -0.5 + 0.01 * jax.random.normal(ks[3], (DEPTH, S5_GROUPS, S5_STATE), f32)
    lam_im = (math.pi * jnp.arange(S5_STATE, dtype=f32)
              + 0.01 * jax.random.normal(ks[4], (DEPTH, S5_GROUPS, S5_STATE), f32))
    log_dt = jax.random.uniform(ks[5], (DEPTH, S5_GROUPS), f32, math.log(DT_MIN), math.log(DT_MAX))
    b_re = nrm(ks[6], (DEPTH, S5_GROUPS, S5_STATE, S5_GROUP), 2 * S5_GROUP)
    b_im = nrm(ks[7], (DEPTH, S5_GROUPS, S5_STATE, S5_GROUP), 2 * S5_GROUP)
    c_re = nrm(ks[8], (DEPTH, S5_GROUPS, S5_GROUP, S5_STATE), 2 * S5_STATE)
    c_im = nrm(ks[9], (DEPTH, S5_GROUPS, S5_GROUP, S5_STATE), 2 * S5_STATE)
    d_skip = jax.random.normal(ks[10], (DEPTH, S5_WIDTH), f32)
    w_glu = nrm(ks[11], (DEPTH, S5_WIDTH, S5_WIDTH), S5_WIDTH)
    b_glu = 0.01 * jax.random.normal(ks[12], (DEPTH, S5_WIDTH), f32)
    s5_up = nrm(ks[13], (DEPTH, S5_WIDTH, D_MODEL), S5_WIDTH)
    w_o = nrm(ks[14], (DEPTH, D_MODEL, D_MODEL), D_MODEL, DN_BETA)
    ln1_g = 1.0 + 0.01 * jax.random.normal(ks[15], (DEPTH, D_MODEL), f32)
    ln1_b = 0.01 * jax.random.normal(ks[16], (DEPTH, D_MODEL), f32)
    w_router = nrm(ks[17], (DEPTH, D_MODEL, N_EXPERTS), D_MODEL)
    router_bias = 0.01 * jax.random.normal(ks[18], (DEPTH, N_EXPERTS), f32)
    w_gate_e = nrm(ks[19], (DEPTH, N_EXPERTS, D_MODEL, EXPERT_HIDDEN), D_MODEL)
    w_up_e = nrm(ks[20], (DEPTH, N_EXPERTS, D_MODEL, EXPERT_HIDDEN), D_MODEL)
    w_down_e = nrm(ks[21], (DEPTH, N_EXPERTS, EXPERT_HIDDEN, D_MODEL), EXPERT_HIDDEN, DN_BETA)
    ws_gate = nrm(ks[22], (DEPTH, D_MODEL, SHARED_HIDDEN), D_MODEL)
    ws_up = nrm(ks[23], (DEPTH, D_MODEL, SHARED_HIDDEN), D_MODEL)
    ws_down = nrm(ks[24], (DEPTH, SHARED_HIDDEN, D_MODEL), SHARED_HIDDEN, DN_BETA)
    ln2_g = 1.0 + 0.01 * jax.random.normal(ks[25], (DEPTH, D_MODEL), f32)
    ln2_b = 0.01 * jax.random.normal(ks[26], (DEPTH, D_MODEL), f32)
    return {'x': x, 'positions': positions, 'w_in': w_in, 'attn_up': attn_up,
            'lam_re': lam_re, 'lam_im': lam_im, 'log_dt': log_dt, 'b_re': b_re, 'b_im': b_im,
            'c_re': c_re, 'c_im': c_im, 'd_skip': d_skip, 'w_glu': w_glu, 'b_glu': b_glu,
            's5_up': s5_up, 'w_o': w_o, 'ln1_g': ln1_g, 'ln1_b': ln1_b,
            'w_router': w_router, 'router_bias': router_bias, 'w_gate_e': w_gate_e,
            'w_up_e': w_up_e, 'w_down_e': w_down_e, 'ws_gate': ws_gate, 'ws_up': ws_up,
            'ws_down': ws_down, 'ln2_g': ln2_g, 'ln2_b': ln2_b}


def reference(x, positions, w_in, attn_up, lam_re, lam_im, log_dt, b_re, b_im, c_re, c_im,
              d_skip, w_glu, b_glu, s5_up, w_o, ln1_g, ln1_b, w_router, router_bias,
              w_gate_e, w_up_e, w_down_e, ws_gate, ws_up, ws_down, ln2_g, ln2_b):
    bsz, seq, _ = x.shape
    cos, sin = rope_tables(positions)
    split_at = [ATTN_WIDTH, 2 * ATTN_WIDTH, 3 * ATTN_WIDTH,
                3 * ATTN_WIDTH + S5_WIDTH, 3 * ATTN_WIDTH + S5_WIDTH + D_MODEL]
    for l in range(DEPTH):
        proj = x @ w_in[l]
        q, k, v, u, g_a, g_s = jnp.split(proj, split_at, axis=-1)
        q = apply_rope(q.reshape(bsz, seq, N_HEADS, HEAD_DIM), cos, sin)
        k = apply_rope(k.reshape(bsz, seq, N_HEADS, HEAD_DIM), cos, sin)
        v = v.reshape(bsz, seq, N_HEADS, HEAD_DIM)
        a = moba_attention(q, k, v) @ attn_up[l]
        s = s5_branch(u, lam_re[l], lam_im[l], log_dt[l], b_re[l], b_im[l], c_re[l], c_im[l],
                      d_skip[l], w_glu[l], b_glu[l]) @ s5_up[l]
        mixed = jax.nn.sigmoid(g_a) * a + jax.nn.sigmoid(g_s) * s
        x = layer_norm(DN_ALPHA * x + mixed @ w_o[l], ln1_g[l], ln1_b[l])
        f = moe_ffn(x, w_router[l], router_bias[l], w_gate_e[l], w_up_e[l], w_down_e[l],
                    ws_gate[l], ws_up[l], ws_down[l])
        x = layer_norm(DN_ALPHA * x + f, ln2_g[l], ln2_b[l])
    return x
```

```cpp
#include <hip/hip_runtime.h>
#include <stdint.h>
#include <stdio.h>

#ifndef N_LAUNCH_MODE
#define N_LAUNCH_MODE 1
#endif

typedef unsigned short bf16_t;
typedef short bf16x8 __attribute__((ext_vector_type(8)));
typedef short bf16x4 __attribute__((ext_vector_type(4)));
typedef float f32x4 __attribute__((ext_vector_type(4)));
typedef float f32x16 __attribute__((ext_vector_type(16)));
typedef unsigned u32x4 __attribute__((ext_vector_type(4)));
typedef unsigned u32x2 __attribute__((ext_vector_type(2)));
typedef float f32x2v __attribute__((ext_vector_type(2)));

constexpr int T_ = 16384, D_ = 1024, S_ = 8192, NBLK = 32, NH = 8, HD = 64;
constexpr int INC = 4096;
constexpr int NE = 256, TOPK = 8, EH = 256;
constexpr float DN_ALPHA = 1.4142135623730951f;
constexpr float LN_EPS = 1e-5f;
constexpr float NEG_INF = -1e30f;
constexpr int NTHR = 256;
constexpr int LDS_BYTES = 80 * 1024;

constexpr size_t MB = 1024ull * 1024ull;
constexpr size_t WS_CTL = 0;
constexpr size_t CTL_BYTES = 262144;
constexpr int ECS = 64, TOS = 16;
constexpr size_t CTL_ECNT = 16384;
constexpr size_t CTL_ATTQ = CTL_ECNT + 2 * 256 * ECS * 4;
constexpr size_t CTL_TOT = CTL_ATTQ + 1024;
constexpr size_t CTL_PCNT = CTL_TOT + 2 * 512 * TOS * 4;
static_assert(CTL_PCNT + 2 * 128 * 64 <= CTL_BYTES, "control block overflow");
constexpr size_t WS_CS = WS_CTL + CTL_BYTES;
constexpr size_t WS_XB = WS_CS + 4 * MB;
constexpr size_t WS_XF = WS_XB + 32 * MB;
constexpr size_t WS_Q = WS_XF + 64 * MB;
constexpr size_t WS_K = WS_Q + 16 * MB;
constexpr size_t WS_VT = WS_K + 16 * MB;
constexpr size_t WS_UG = WS_VT + 16 * MB;
constexpr size_t WS_GA = WS_UG + 16 * MB;
constexpr size_t WS_GS = WS_GA + 32 * MB;
constexpr size_t WS_KMEAN = WS_GS + 32 * MB;
constexpr size_t WS_CNT = WS_KMEAN + 1 * MB;
constexpr size_t WS_LIST = WS_CNT + 1 * MB;
constexpr size_t WS_LSE = WS_LIST + 8 * MB;
constexpr size_t WS_PO = WS_LSE + 2 * MB;
constexpr size_t WS_AO = WS_PO + 64 * MB;
constexpr size_t WS_TM = WS_AO + 16 * MB;
constexpr size_t WS_WE = WS_TM + 32 * MB;
constexpr size_t WS_WC = WS_WE + 8 * MB;
constexpr size_t WS_AL = WS_WC + 8 * MB;
constexpr size_t WS_E = WS_AL + 1 * MB;
constexpr size_t WS_HIN = WS_E + 8 * MB;
constexpr size_t WS_Z = WS_HIN + 4 * MB;
constexpr size_t WS_SGL = WS_Z + 16 * MB;
constexpr size_t WS_MIX = WS_SGL + 16 * MB;
constexpr size_t WS_Y1 = WS_MIX + 32 * MB;
constexpr size_t WS_X1F = WS_Y1 + 64 * MB;
constexpr size_t WS_PST = WS_X1F;
constexpr size_t WS_X1B = WS_X1F + 64 * MB;
constexpr size_t WS_SC = WS_X1B + 32 * MB;
constexpr size_t WS_HS = WS_SC + 16 * MB;
constexpr size_t WS_ROWL = WS_HS + 8 * MB;
constexpr size_t WS_HBUF = WS_ROWL + 32 * MB;
constexpr size_t WS_YBUF = WS_HBUF + 64 * MB;
constexpr size_t WS_WI = WS_YBUF + 256 * MB;
constexpr size_t WS_WA = WS_WI + 16 * MB;
constexpr size_t WS_WSU = WS_WA + 2 * MB;
constexpr size_t WS_WG = WS_WSU + 2 * MB;
constexpr size_t WS_WO = WS_WG + 1 * MB;
constexpr size_t WS_WRS = WS_WO + 4 * MB;
constexpr size_t WS_WSD = WS_WRS + 3 * MB;
constexpr size_t WS_KM = WS_WSD + 1 * MB;
constexpr size_t WS_END = WS_KM + 2 * MB;

struct Params {
    const float* x; const int* positions; const float* w_in; const float* attn_up;
    const float* lam_re; const float* lam_im; const float* log_dt; const float* b_re; const float* b_im;
    const float* c_re; const float* c_im; const float* d_skip; const float* w_glu; const float* b_glu;
    const float* s5_up; const float* w_o; const float* ln1_g; const float* ln1_b;
    const float* w_router; const float* router_bias; const float* w_gate_e; const float* w_up_e; const float* w_down_e;
    const float* ws_gate; const float* ws_up; const float* ws_down; const float* ln2_g; const float* ln2_b;
    float* out; unsigned char* ws;
    int ph_lo, ph_hi;
};

typedef const __attribute__((address_space(4))) Params CParams;

#define XB_TMO      128
#define XB_XCNT(j)  (256  + 64 * (j))
#define XB_XSUB(j)  (1280 + 64 * (j))
#define XB_XGEN(j)  (2304 + 64 * (j))
#define XB_TOP      3328
#define XB_TOPGEN   3392
#define XCD_BAR_WORDS 3456
#define XB_SPIN_CAP (1u << 22)
#define LAS __attribute__((address_space(3)))

__device__ __forceinline__ unsigned xb_ld(unsigned* p)              { return __hip_atomic_load(p, __ATOMIC_RELAXED, __HIP_MEMORY_SCOPE_AGENT); }
__device__ __forceinline__ unsigned xb_add(unsigned* p, unsigned v) { return __hip_atomic_fetch_add(p, v, __ATOMIC_RELAXED, __HIP_MEMORY_SCOPE_AGENT); }
__device__ __forceinline__ unsigned xb_xcc_id() { return (unsigned)__builtin_amdgcn_s_getreg((3 << 11) | 20) & 0xFu; }
#define XB_SPIN(cond, bar) do { unsigned _sp = 0; while (cond) { __builtin_amdgcn_s_sleep(1); \
    if ((++_sp & 255u) == 0u) { if (xb_ld(&(bar)[XB_TMO])) break; if (_sp > XB_SPIN_CAP) { atomicAdd(&(bar)[XB_TMO], 1u); break; } } } } while (0)

struct XcdBarrier { unsigned* bar; unsigned x; unsigned nloc, nx; };

__device__ __forceinline__ XcdBarrier xcd_barrier_post(unsigned* bar) {
    XcdBarrier b; b.bar = bar; b.x = xb_xcc_id(); b.nloc = 0u; b.nx = 0u;
    if (threadIdx.x == 0) (void)xb_add(&bar[XB_XCNT(b.x)], 1u);
    return b;
}
__device__ __forceinline__ void xcd_barrier_complete(unsigned* bar, unsigned x, unsigned& nloc, unsigned& nx) {
    const unsigned G = gridDim.x * gridDim.y * gridDim.z;
    unsigned sum, cnt, mine, sp = 0u;
    for (;;) {
        sum = 0u; cnt = 0u; mine = 0u;
#pragma unroll
        for (unsigned j = 0; j < 16; ++j) { const unsigned c = xb_ld(&bar[XB_XCNT(j)]); sum += c; cnt += (c > 0u) ? 1u : 0u; mine = (j == x) ? c : mine; }
        if (sum == G) break;
        __builtin_amdgcn_s_sleep(1);
        if ((++sp & 255u) == 0u) { if (xb_ld(&bar[XB_TMO])) break; if (sp > XB_SPIN_CAP) { atomicAdd(&bar[XB_TMO], 1u); break; } }
    }
    nloc = mine > 0u ? mine : 1u; nx = cnt > 0u ? cnt : 1u;
}
__device__ __forceinline__ void xcd_barrier(XcdBarrier& b) {
    asm volatile("s_waitcnt vmcnt(0)" ::: "memory");
    __syncthreads();
    if (threadIdx.x == 0) {
        unsigned* bar = b.bar;
        __builtin_amdgcn_s_waitcnt(0);
        unsigned nloc = b.nloc, nx = b.nx;
        if (nloc == 0u) { xcd_barrier_complete(bar, b.x, nloc, nx); b.nloc = nloc; b.nx = nx; }
        const unsigned old = xb_add(&bar[XB_XSUB(b.x)], 1u);
        const unsigned gen = old / nloc;
        if (old + 1u == (gen + 1u) * nloc) {
            __builtin_amdgcn_fence(__ATOMIC_RELEASE, "agent");
            asm volatile("s_waitcnt vmcnt(0)" ::: "memory");
            const unsigned og = xb_add(&bar[XB_TOP], 1u);
            const unsigned tg = og / nx;
            if (og + 1u == (tg + 1u) * nx) xb_add(&bar[XB_TOPGEN], 1u);
            else XB_SPIN(xb_ld(&bar[XB_TOPGEN]) == tg, bar);
            __builtin_amdgcn_fence(__ATOMIC_ACQUIRE, "agent");
            xb_add(&bar[XB_XGEN(b.x)], 1u);
            asm volatile("s_waitcnt vmcnt(0)" ::: "memory");
        } else {
            XB_SPIN(xb_ld(&bar[XB_XGEN(b.x)]) == gen, bar);
            __builtin_amdgcn_fence(__ATOMIC_ACQUIRE, "agent");
            asm volatile("s_waitcnt vmcnt(0)" ::: "memory");
        }
    }
    __syncthreads();
}

__device__ __forceinline__ unsigned cvt_pk_bf16(float lo, float hi) { unsigned r; asm volatile("v_cvt_pk_bf16_f32 %0, %1, %2" : "=v"(r) : "v"(lo), "v"(hi)); return r; }
__device__ __forceinline__ bf16_t f2bf(float f) { return (bf16_t)(cvt_pk_bf16(f, 0.f) & 0xffffu); }
__device__ __forceinline__ float bf2f(unsigned v) { return __uint_as_float(v << 16); }
__device__ __forceinline__ float bflo(unsigned w) { return __uint_as_float(w << 16); }
__device__ __forceinline__ float bfhi(unsigned w) { return __uint_as_float(w & 0xffff0000u); }
__device__ __forceinline__ float sigmoidf_(float v) { return __builtin_amdgcn_rcpf(1.f + __expf(-v)); }
__device__ __forceinline__ float siluf_(float v) { return v * __builtin_amdgcn_rcpf(1.f + __expf(-v)); }
__device__ __forceinline__ float gelu_tanh(float v) {
    const float u = 0.7978845608028654f * (v + 0.044715f * v * v * v);
    const float e = __expf(2.f * u);
    const float th = 1.f - 2.f * __builtin_amdgcn_rcpf(1.f + e);
    return 0.5f * v * (1.f + th);
}
template <class T> __device__ __forceinline__ T* gptr(T* q) { return (T*)(__attribute__((address_space(1))) T*)q; }
__device__ __forceinline__ int otid() { int t = threadIdx.x; asm volatile("" : "+v"(t)); return t; }
__device__ __forceinline__ int obid() { int b = blockIdx.x; asm volatile("" : "+s"(b)); return b; }
__device__ __forceinline__ int vblock() {
    const int G = gridDim.x, b = obid();
    if ((G & 7) == 0) return (b & 7) * (G >> 3) + (b >> 3);
    return b;
}

constexpr int GA_BYTES = 128 * 64 * 2;

#define AS1 __attribute__((address_space(1)))
__device__ __forceinline__ void dma16(const void* g, unsigned char* lds_wave_base) {
    __builtin_amdgcn_global_load_lds((const AS1 unsigned*)g, (LAS unsigned*)lds_wave_base, 16, 0, 0);
}
__device__ __forceinline__ int dma_row(int t, int q) { return 32 * (t >> 6) + 8 * q + ((t & 63) >> 3); }
__device__ __forceinline__ int dma_koff(int t, int q) { return 8 * ((t & 7) ^ ((4 * q + ((t & 63) >> 4)) & 7)); }

__device__ __forceinline__ void gemm_step(f32x4 (&acc)[4][4], const unsigned char* A, const unsigned char* B, int ra0, int ra1, int rb0, int rb1) {
#pragma unroll
    for (int s = 0; s < 2; ++s) {
        bf16x8 af[4], bf[4];
#pragma unroll
        for (int i = 0; i < 4; ++i) af[i] = *(const bf16x8*)(A + (s ? ra1 : ra0) + i * 2048);
#pragma unroll
        for (int j = 0; j < 4; ++j) bf[j] = *(const bf16x8*)(B + (s ? rb1 : rb0) + j * 2048);
        __builtin_amdgcn_s_setprio(1);
#pragma unroll
        for (int i = 0; i < 4; ++i)
#pragma unroll
            for (int j = 0; j < 4; ++j) acc[i][j] = __builtin_amdgcn_mfma_f32_16x16x32_bf16(bf[j], af[i], acc[i][j], 0, 0, 0);
        __builtin_amdgcn_s_setprio(0);
    }
}

__device__ __forceinline__ void gemm_kloop_dd(f32x4 (&acc)[4][4], unsigned char* smem, const bf16_t* (&ap)[4], const bf16_t* (&bq)[4], int nk) {
    const int t = otid(), lane = t & 63, wid = __builtin_amdgcn_readfirstlane(t >> 6), wr = wid >> 1, wc = wid & 1, l15 = lane & 15, kg = lane >> 4;
    const int sw = (l15 >> 1) & 7;
    const int ra0 = (wr * 64 + l15) * 128 + (((0 + kg) ^ sw) << 4), ra1 = (wr * 64 + l15) * 128 + (((4 + kg) ^ sw) << 4);
    const int rb0 = (wc * 64 + l15) * 128 + (((0 + kg) ^ sw) << 4), rb1 = (wc * 64 + l15) * 128 + (((4 + kg) ^ sw) << 4);
    unsigned char* wbase = smem + wid * 4096;
    auto issue = [&](int stage) {
#pragma unroll
        for (int q = 0; q < 4; ++q) { dma16(ap[q], wbase + stage * 32768 + q * 1024); ap[q] += 64; }
#pragma unroll
        for (int q = 0; q < 4; ++q) { dma16(bq[q], wbase + stage * 32768 + 16384 + q * 1024); bq[q] += 64; }
    };
    issue(0);
    asm volatile("s_waitcnt vmcnt(0)" ::: "memory");
    __syncthreads();
    for (int kt = 0; kt < nk; ++kt) {
        if (kt + 1 < nk) issue((kt + 1) & 1);
        const unsigned char* A = smem + (kt & 1) * 32768;
        gemm_step(acc, A, A + 16384, ra0, ra1, rb0, rb1);
        asm volatile("s_waitcnt vmcnt(0)" ::: "memory");
        __syncthreads();
    }
}

__device__ __forceinline__ void gemm_kloop_df(f32x4 (&acc)[4][4], unsigned char* smem, const bf16_t* (&ap)[4], const float* bp, size_t ldb, int nk) {
    const int t = otid(), lane = t & 63, wid = __builtin_amdgcn_readfirstlane(t >> 6), wr = wid >> 1, wc = wid & 1, l15 = lane & 15, kg = lane >> 4;
    const int sw = (l15 >> 1) & 7;
    const int ra0 = (wr * 64 + l15) * 128 + (((0 + kg) ^ sw) << 4), ra1 = (wr * 64 + l15) * 128 + (((4 + kg) ^ sw) << 4);
    const int rb0 = (wc * 64 + l15) * 128 + (((0 + kg) ^ sw) << 4), rb1 = (wc * 64 + l15) * 128 + (((4 + kg) ^ sw) << 4);
    const int bqd = t & 31, bc = t >> 5;
    unsigned char* wbase = smem + wid * 4096;
    unsigned char* Bst = smem + 49152;
    f32x4 rB0[8], rB1[8];
    int sa_i = 0, sa_r = 0;
#define DF_ISSUE_A() do { _Pragma("unroll") for (int q = 0; q < 4; ++q) { dma16(ap[q], wbase + sa_i * 16384 + q * 1024); ap[q] += 64; } asm volatile("" ::: "memory"); sa_i = (sa_i == 2) ? 0 : sa_i + 1; } while (0)
#define DF_LOAD_B(R) do { _Pragma("unroll") for (int j = 0; j < 8; ++j) R[j] = *(const f32x4*)(bp + (size_t)j * ldb); bp += 64 * ldb; asm volatile("" ::: "memory"); } while (0)
#define DF_STORE_B(R, stage) do { unsigned char* B_ = Bst + (stage) * 16384; _Pragma("unroll") for (int ii = 0; ii < 4; ++ii) { u32x4 v_; \
        v_[0] = cvt_pk_bf16(R[0][ii], R[1][ii]); v_[1] = cvt_pk_bf16(R[2][ii], R[3][ii]); v_[2] = cvt_pk_bf16(R[4][ii], R[5][ii]); v_[3] = cvt_pk_bf16(R[6][ii], R[7][ii]); \
        const int row_ = 4 * bqd + ii; *(u32x4*)(B_ + row_ * 128 + ((bc ^ ((row_ >> 1) & 7)) << 4)) = v_; } } while (0)
#define DF_SYNC(keep) do { if (keep) asm volatile("s_waitcnt vmcnt(12)" ::: "memory"); else asm volatile("s_waitcnt vmcnt(0)" ::: "memory"); asm volatile("s_waitcnt lgkmcnt(0)" ::: "memory"); __builtin_amdgcn_s_barrier(); asm volatile("" ::: "memory"); } while (0)
#define DF_COMPUTE(bstage) do { gemm_step(acc, smem + sa_r * 16384, Bst + (bstage) * 16384, ra0, ra1, rb0, rb1); sa_r = (sa_r == 2) ? 0 : sa_r + 1; } while (0)
    DF_ISSUE_A(); DF_LOAD_B(rB0);
    if (nk > 1) { DF_ISSUE_A(); DF_LOAD_B(rB1); }
    DF_STORE_B(rB0, 0);
    DF_SYNC(nk > 1);
    for (int kt = 0; kt < nk; kt += 2) {
        if (kt + 2 < nk) { DF_ISSUE_A(); DF_LOAD_B(rB0); }
        DF_COMPUTE(0);
        if (kt + 1 < nk) DF_STORE_B(rB1, 1);
        DF_SYNC(kt + 2 < nk);
        if (kt + 1 >= nk) break;
        if (kt + 3 < nk) { DF_ISSUE_A(); DF_LOAD_B(rB1); }
        DF_COMPUTE(1);
        if (kt + 2 < nk) DF_STORE_B(rB0, 0);
        DF_SYNC(kt + 3 < nk);
    }
#undef DF_ISSUE_A
#undef DF_LOAD_B
#undef DF_STORE_B
#undef DF_SYNC
#undef DF_COMPUTE
}

__device__ __forceinline__ void gemm_step_lr(f32x4 (&acc)[4][4], const unsigned char* A, const unsigned char* B, int ra0, int ra1, int rb0, int rb1) {
#pragma unroll
    for (int s = 0; s < 2; ++s) {
        bf16x8 af[4];
#pragma unroll
        for (int i = 0; i < 4; ++i) af[i] = *(const bf16x8*)(A + (s ? ra1 : ra0) + i * 2048);
#pragma unroll
        for (int j = 0; j < 4; ++j) {
            const bf16x8 bf = *(const bf16x8*)(B + (s ? rb1 : rb0) + j * 2048);
#pragma unroll
            for (int i = 0; i < 4; ++i) acc[i][j] = __builtin_amdgcn_mfma_f32_16x16x32_bf16(bf, af[i], acc[i][j], 0, 0, 0);
            __builtin_amdgcn_sched_barrier(0);
        }
    }
}
__device__ __forceinline__ void gemm_kloop_df2(f32x4 (&acc0)[4][4], f32x4 (&acc1)[4][4], unsigned char* smem, const unsigned char* abase, unsigned (&ap0)[4], unsigned (&ap1)[4], const float* bp, size_t ldb, int nk, bool has1) {
    const int t = otid(), lane = t & 63, wid = __builtin_amdgcn_readfirstlane(t >> 6), wr = wid >> 1, wc = wid & 1, l15 = lane & 15, kg = lane >> 4;
    const int sw = (l15 >> 1) & 7;
    const int ra0 = (wr * 64 + l15) * 128 + (((0 + kg) ^ sw) << 4), ra1 = (wr * 64 + l15) * 128 + (((4 + kg) ^ sw) << 4);
    const int rb0 = (wc * 64 + l15) * 128 + (((0 + kg) ^ sw) << 4), rb1 = (wc * 64 + l15) * 128 + (((4 + kg) ^ sw) << 4);
    const int bqd = t & 31, bc = t >> 5;
    unsigned char* wbase = smem + wid * 4096;
    unsigned char* Bst = smem + 49152;
    f32x4 rB[4];
    int sa_i = 0, sa_r = 0;
#define D2_ISSUE(AP) do { _Pragma("unroll") for (int q = 0; q < 4; ++q) { dma16(abase + AP[q], wbase + sa_i * 16384 + q * 1024); AP[q] += 128u; } asm volatile("" ::: "memory"); sa_i = (sa_i == 2) ? 0 : sa_i + 1; } while (0)
#define D2_LOAD_BH(h) do { _Pragma("unroll") for (int j = 0; j < 4; ++j) rB[j] = *(const f32x4*)(bp + (size_t)(4 * (h) + j) * ldb); asm volatile("" ::: "memory"); } while (0)
#define D2_STORE_BH(stage, h) do { unsigned char* B_ = Bst + (stage) * 16384; _Pragma("unroll") for (int ii = 0; ii < 4; ++ii) { u32x2 v_; \
        v_[0] = cvt_pk_bf16(rB[0][ii], rB[1][ii]); v_[1] = cvt_pk_bf16(rB[2][ii], rB[3][ii]); \
        const int row_ = 4 * bqd + ii; *(u32x2*)(B_ + row_ * 128 + ((bc ^ ((row_ >> 1) & 7)) << 4) + 8 * (h)) = v_; } } while (0)
#define D2_BAR(inflight) do { if (inflight) asm volatile("s_waitcnt vmcnt(4)" ::: "memory"); else asm volatile("s_waitcnt vmcnt(0)" ::: "memory"); asm volatile("s_waitcnt lgkmcnt(0)" ::: "memory"); __builtin_amdgcn_s_barrier(); asm volatile("" ::: "memory"); } while (0)
#define D2_COMPUTE(ACC, bstage) do { gemm_step_lr(ACC, smem + sa_r * 16384, Bst + (bstage) * 16384, ra0, ra1, rb0, rb1); sa_r = (sa_r == 2) ? 0 : sa_r + 1; } while (0)
    {
        f32x4 rP[4];
        D2_LOAD_BH(0);
#pragma unroll
        for (int j = 0; j < 4; ++j) rP[j] = *(const f32x4*)(bp + (size_t)(4 + j) * ldb);
        asm volatile("" ::: "memory");
        D2_STORE_BH(0, 0);
#pragma unroll
        for (int j = 0; j < 4; ++j) rB[j] = rP[j];
        D2_STORE_BH(0, 1);
    }
    bp += 64 * ldb;
    D2_ISSUE(ap0);
    if (has1) D2_ISSUE(ap1);
    D2_BAR(false);
    for (int k = 0; k < nk; ++k) {
        const bool more = (k + 1 < nk);
        const int bs = k & 1;
        if (more) { D2_LOAD_BH(0); D2_ISSUE(ap0); }
        D2_COMPUTE(acc0, bs);
        if (more) D2_STORE_BH(bs ^ 1, 0);
        D2_BAR(more);
        if (more) D2_LOAD_BH(1);
        if (has1) {
            if (more) D2_ISSUE(ap1);
            D2_COMPUTE(acc1, bs);
        }
        if (more) { D2_STORE_BH(bs ^ 1, 1); bp += 64 * ldb; }
        D2_BAR(more && has1);
    }
#undef D2_ISSUE
#undef D2_LOAD_BH
#undef D2_STORE_BH
#undef D2_BAR
#undef D2_COMPUTE
}

__device__ __forceinline__ void gemm_dd(f32x4 (&acc)[4][4], unsigned char* smem, const bf16_t* A, size_t lda, int m0, const bf16_t* Bt, size_t ldbt, int n0, int nk) {
    const int t = otid();
    const bf16_t* ap[4]; const bf16_t* bq[4];
#pragma unroll
    for (int q = 0; q < 4; ++q) { ap[q] = A + (size_t)(m0 + dma_row(t, q)) * lda + dma_koff(t, q); bq[q] = Bt + (size_t)(n0 + dma_row(t, q)) * ldbt + dma_koff(t, q); }
    gemm_kloop_dd(acc, smem, ap, bq, nk);
}

struct TileSched {
    int x, rank, R, nN, SN, SM, n_sn, U;
    __device__ __forceinline__ void init(int vb, int G, int nN_) { R = G >> 3; x = vb / R; rank = vb % R; nN = nN_; SN = nN < 8 ? nN : 8; SM = nN <= 4 ? 16 : 8; n_sn = nN / SN; U = 16 * nN; }
    __device__ __forceinline__ void get(int i, int& mt, int& nt) const { const int P = SM * SN, st = i / P, w = i % P, mg = st / n_sn, ng = st % n_sn; mt = 16 * x + SM * mg + (w % SM); nt = SN * ng + (w / SM); }
};

__device__ __forceinline__ void zero_acc(f32x4 (&acc)[4][4]) {
#pragma unroll
    for (int i = 0; i < 4; ++i)
#pragma unroll
        for (int j = 0; j < 4; ++j) acc[i][j] = (f32x4){0.f, 0.f, 0.f, 0.f};
}

#define EPI_IDX const int _t = otid(), _lane = _t & 63, _wid = _t >> 6, _wr = _wid >> 1, _wc = _wid & 1, _l15 = _lane & 15, _kg = _lane >> 4

__device__ __forceinline__ void st_bf16x4(bf16_t* p, float a, float b, float c, float d) { u32x2 v; v[0] = cvt_pk_bf16(a, b); v[1] = cvt_pk_bf16(c, d); *(u32x2*)p = v; }

static __device__ __forceinline__ void ph_prologue(CParams& p, unsigned char* smem) {
    const int G = gridDim.x, b = obid(), t = otid();
    {
        float2* cs = gptr((float2*)(p.ws + WS_CS));
        for (int idx = b * NTHR + t; idx < T_ * 32; idx += G * NTHR) {
            const int tok = idx >> 5, f = idx & 31;
            const float inv = powf(10000.f, -(float)(2 * f) / 64.f);
            const float ang = (float)gptr(p.positions)[tok] * inv;
            float s, c; sincosf(ang, &s, &c);
            cs[idx] = make_float2(c, s);
        }
    }
    {
        bf16_t* xb = gptr((bf16_t*)(p.ws + WS_XB));
        for (size_t idx = (size_t)b * NTHR + t; idx < (size_t)T_ * D_ / 4; idx += (size_t)G * NTHR) {
            const f32x4 v = *(const f32x4*)(gptr(p.x) + idx * 4);
            st_bf16x4(xb + idx * 4, v[0], v[1], v[2], v[3]);
        }
    }
    {
        for (int u = b; u < 2 * 928; u += G) {
            const int l = u / 928; int r = u % 928;
            const float* src; bf16_t* dst; int K, N, kt, ntl;
            const int nq = t & 31, kk = t >> 5;
            const float* sp; int drow;
            if (r < 512) { K = 1024; N = 4096; kt = r >> 5; ntl = r & 31; src = gptr(p.w_in) + (size_t)l * 1024 * 4096; dst = gptr((bf16_t*)(p.ws + WS_WI)) + (size_t)l * 4096 * 1024; drow = ntl * 128 + 4 * nq; sp = src + drow; }
            else if (r < 576) { r -= 512; K = 512; N = 1024; kt = r >> 3; ntl = r & 7; src = gptr(p.attn_up) + (size_t)l * 512 * 1024; dst = gptr((bf16_t*)(p.ws + WS_WA)) + (size_t)l * 1024 * 512; drow = ntl * 128 + 4 * nq; sp = src + drow; }
            else if (r < 640) { r -= 576; K = 512; N = 1024; kt = r >> 3; ntl = r & 7; src = gptr(p.s5_up) + (size_t)l * 512 * 1024; dst = gptr((bf16_t*)(p.ws + WS_WSU)) + (size_t)l * 1024 * 512; drow = ntl * 128 + 4 * nq; sp = src + drow; }
            else if (r < 672) { r -= 640; K = 512; N = 512; kt = r >> 2; ntl = r & 3; src = gptr(p.w_glu) + (size_t)l * 512 * 512; dst = gptr((bf16_t*)(p.ws + WS_WG)) + (size_t)l * 512 * 512; drow = ntl * 128 + 4 * nq; sp = src + drow; }
            else if (r < 800) { r -= 672; K = 1024; N = 1024; kt = r >> 3; ntl = r & 7; src = gptr(p.w_o) + (size_t)l * 1024 * 1024; dst = gptr((bf16_t*)(p.ws + WS_WO)) + (size_t)l * 1024 * 1024; drow = ntl * 128 + 4 * nq; sp = src + drow; }
            else if (r < 896) { r -= 800; K = 1024; N = 256; kt = r / 6; ntl = r % 6; dst = gptr((bf16_t*)(p.ws + WS_WRS)) + (size_t)l * 768 * 1024; drow = ntl * 128 + 4 * nq;
                if (ntl < 2) sp = gptr(p.w_router) + (size_t)l * 1024 * 256 + drow;
                else { const int n = 4 * nq, wcq = n >> 6, s = (n >> 5) & 1, rr = n & 31; sp = (s ? gptr(p.ws_up) : gptr(p.ws_gate)) + (size_t)l * 1024 * 256 + (ntl - 2) * 64 + 32 * wcq + rr; } }
            else { r -= 896; K = 256; N = 1024; kt = r >> 3; ntl = r & 7; src = gptr(p.ws_down) + (size_t)l * 256 * 1024; dst = gptr((bf16_t*)(p.ws + WS_WSD)) + (size_t)l * 1024 * 256; drow = ntl * 128 + 4 * nq; sp = src + drow; }
            f32x4 v[8];
#pragma unroll
            for (int j = 0; j < 8; ++j) v[j] = *(const f32x4*)(sp + (size_t)(kt * 64 + kk * 8 + j) * N);
#pragma unroll
            for (int ii = 0; ii < 4; ++ii) {
                u32x4 o; o[0] = cvt_pk_bf16(v[0][ii], v[1][ii]); o[1] = cvt_pk_bf16(v[2][ii], v[3][ii]); o[2] = cvt_pk_bf16(v[4][ii], v[5][ii]); o[3] = cvt_pk_bf16(v[6][ii], v[7][ii]);
                *(u32x4*)(dst + (size_t)(drow + ii) * K + kt * 64 + kk * 8) = o;
            }
        }
    }
    float2* s_apow = (float2*)smem;
    float2* s_bbar = (float2*)(smem + 33 * 64 * 8);
    float2* s_c = (float2*)(smem + 33 * 64 * 8 + 8192);
    float* s_km = (float*)(smem + 33 * 64 * 8 + 16384);
    for (int u2 = b; u2 < 512; u2 += G) {
        const int u = u2 >> 3, sl = u2 & 7, l = u >> 5, g = u & 31;
        const float dtf = expf(gptr(p.log_dt)[l * 32 + g]);
        __syncthreads();
        for (int idx = t; idx < 33 * 64; idx += NTHR) {
            const int d = idx >> 6, n = idx & 63;
            const double lr = (double)gptr(p.lam_re)[(l * 32 + g) * 64 + n], li = (double)gptr(p.lam_im)[(l * 32 + g) * 64 + n];
            const double mag = exp(lr * (double)dtf * d); double sn, cn; sincos(li * (double)dtf * d, &sn, &cn);
            s_apow[idx] = make_float2((float)(mag * cn), (float)(mag * sn));
        }
        for (int idx = t; idx < 64 * 16; idx += NTHR) {
            const int n = idx >> 4, c = idx & 15;
            const float lr = gptr(p.lam_re)[(l * 32 + g) * 64 + n], li = gptr(p.lam_im)[(l * 32 + g) * 64 + n];
            const float mag = expf(lr * dtf); const float are = mag * cosf(li * dtf), aim = mag * sinf(li * dtf);
            const float den = lr * lr + li * li, nr = are - 1.f;
            const float cre = (nr * lr + aim * li) / den, cim = (aim * lr - nr * li) / den;
            const float br = gptr(p.b_re)[((size_t)(l * 32 + g) * 64 + n) * 16 + c], bi = gptr(p.b_im)[((size_t)(l * 32 + g) * 64 + n) * 16 + c];
            s_bbar[idx] = make_float2(cre * br - cim * bi, cre * bi + cim * br);
            const int cc = idx >> 6, nn = idx & 63;
            s_c[idx] = make_float2(gptr(p.c_re)[((size_t)(l * 32 + g) * 16 + cc) * 64 + nn], gptr(p.c_im)[((size_t)(l * 32 + g) * 16 + cc) * 64 + nn]);
        }
        __syncthreads();
        {
            float* km = gptr((float*)(p.ws + WS_KM)) + (size_t)u * 8192;
            for (int idx = t + sl * 1024; idx < (sl + 1) * 1024; idx += NTHR) {
                const int d = idx >> 8, c = (idx >> 4) & 15, c2 = idx & 15;
                float acc = 0.f;
                for (int n = 0; n < 64; ++n) {
                    const float2 a = s_apow[d * 64 + n], bb = s_bbar[n * 16 + c2], cv = s_c[c * 64 + n];
                    const float tr = a.x * bb.x - a.y * bb.y, ti = a.x * bb.y + a.y * bb.x;
                    acc += cv.x * tr - cv.y * ti;
                }
                km[idx] = acc;
            }
        }
        bf16_t* We = gptr((bf16_t*)(p.ws + WS_WE)) + (size_t)u * 128 * 512;
        for (int ch = t + sl * 1024; ch < (sl + 1) * 1024; ch += NTHR) {
            const int row = ch >> 6, c8 = ch & 63, ri = row >> 6, n = row & 63, j = c8 >> 1, cb = (c8 & 1) * 8;
            const float2 a = s_apow[(31 - j) * 64 + n];
            float v[8];
#pragma unroll
            for (int e = 0; e < 8; ++e) { const float2 bb = s_bbar[n * 16 + cb + e]; v[e] = ri ? (a.x * bb.y + a.y * bb.x) : (a.x * bb.x - a.y * bb.y); }
            u32x4 o; o[0] = cvt_pk_bf16(v[0], v[1]); o[1] = cvt_pk_bf16(v[2], v[3]); o[2] = cvt_pk_bf16(v[4], v[5]); o[3] = cvt_pk_bf16(v[6], v[7]);
            *(u32x4*)(We + (size_t)row * 512 + c8 * 8) = o;
        }
        bf16_t* Wc = gptr((bf16_t*)(p.ws + WS_WC)) + (size_t)u * 512 * 128;
        for (int ch = t + sl * 1024; ch < (sl + 1) * 1024; ch += NTHR) {
            const int row = ch >> 4, c8 = ch & 15, i = row >> 4, c = row & 15, ri = c8 >> 3, nb = (c8 & 7) * 8;
            float v[8];
#pragma unroll
            for (int e = 0; e < 8; ++e) { const int n = nb + e; const float2 a = s_apow[(i + 1) * 64 + n], cv = s_c[c * 64 + n];
                v[e] = ri ? -(cv.x * a.y + cv.y * a.x) : (cv.x * a.x - cv.y * a.y); }
            u32x4 o; o[0] = cvt_pk_bf16(v[0], v[1]); o[1] = cvt_pk_bf16(v[2], v[3]); o[2] = cvt_pk_bf16(v[4], v[5]); o[3] = cvt_pk_bf16(v[6], v[7]);
            *(u32x4*)(Wc + (size_t)row * 128 + c8 * 8) = o;
        }
        float2* aL = gptr((float2*)(p.ws + WS_AL)) + u * 64;
        if (t < 64 && sl == 0) aL[t] = s_apow[32 * 64 + t];
    }
}

static __device__ __forceinline__ void ph_inproj(CParams& p, int l, unsigned char* smem) {
    EPI_IDX;
    const bf16_t* xb = gptr((const bf16_t*)(p.ws + WS_XB));
    const bf16_t* Wt = gptr((const bf16_t*)(p.ws + WS_WI)) + (size_t)l * INC * D_;
    const float2* cs = gptr((const float2*)(p.ws + WS_CS));
    bf16_t* qo = gptr((bf16_t*)(p.ws + WS_Q)); bf16_t* ko = gptr((bf16_t*)(p.ws + WS_K)); bf16_t* vto = gptr((bf16_t*)(p.ws + WS_VT));
    bf16_t* ugo = gptr((bf16_t*)(p.ws + WS_UG)); bf16_t* gao = gptr((bf16_t*)(p.ws + WS_GA)); bf16_t* gso = gptr((bf16_t*)(p.ws + WS_GS));
    const int G = gridDim.x, vb = vblock();
    TileSched ts; ts.init(vb, G, INC / 128);
    for (int u = ts.rank; u < ts.U; u += ts.R) {
        int mt, nt; ts.get(u, mt, nt);
        const int m0 = mt * 128, n0 = nt * 128;
        f32x4 acc[4][4]; zero_acc(acc);
        gemm_dd(acc, smem, xb, D_, m0, Wt, D_, n0, D_ / 64);
        const int nw = n0 + 64 * _wc;
        if (nw < 1024) {
            const bool isq = nw < 512; const int hcol = nw & 511; bf16_t* dst = isq ? qo : ko; const float sc = isq ? 0.125f : 1.f;
#pragma unroll
            for (int i = 0; i < 4; ++i) {
                const int m = m0 + 64 * _wr + 16 * i + _l15;
#pragma unroll
                for (int j = 0; j < 2; ++j) {
                    const int f0 = 16 * j + 4 * _kg;
                    const f32x4 c01 = *(const f32x4*)(cs + (size_t)m * 32 + f0), c23 = *(const f32x4*)(cs + (size_t)m * 32 + f0 + 2);
                    const float cc[4] = {c01[0], c01[2], c23[0], c23[2]}, ss[4] = {c01[1], c01[3], c23[1], c23[3]};
                    float o1[4], o2[4];
#pragma unroll
                    for (int e = 0; e < 4; ++e) { const float t1 = acc[i][j][e], t2 = acc[i][j + 2][e]; o1[e] = (t1 * cc[e] - t2 * ss[e]) * sc; o2[e] = (t2 * cc[e] + t1 * ss[e]) * sc; }
                    st_bf16x4(dst + (size_t)m * 512 + hcol + f0, o1[0], o1[1], o1[2], o1[3]);
                    st_bf16x4(dst + (size_t)m * 512 + hcol + 32 + f0, o2[0], o2[1], o2[2], o2[3]);
                }
            }
        } else if (nw < 1536) {
            const int h = (nw - 1024) >> 6;
#pragma unroll
            for (int i = 0; i < 4; ++i) {
                const int m = m0 + 64 * _wr + 16 * i + _l15, bb = m >> 13, s = m & 8191;
#pragma unroll
                for (int j = 0; j < 4; ++j)
#pragma unroll
                    for (int e = 0; e < 4; ++e) { const int d = 16 * j + 4 * _kg + e; vto[((size_t)(bb * 8 + h) * 64 + d) * S_ + s] = f2bf(acc[i][j][e]); }
            }
        } else if (nw < 2048) {
            const int g0 = (nw - 1536) >> 4;
#pragma unroll
            for (int i = 0; i < 4; ++i) {
                const int m = m0 + 64 * _wr + 16 * i + _l15;
#pragma unroll
                for (int j = 0; j < 4; ++j) st_bf16x4(ugo + ((size_t)(g0 + j) * T_ + m) * 16 + 4 * _kg, acc[i][j][0], acc[i][j][1], acc[i][j][2], acc[i][j][3]);
            }
        } else {
            unsigned char* dst = (unsigned char*)((nw < 3072) ? gao : gso); const int c0 = (nw < 3072) ? nw - 2048 : nw - 3072;
#pragma unroll
            for (int i = 0; i < 4; ++i) {
                const int m = m0 + 64 * _wr + 16 * i + _l15;
#pragma unroll
                for (int j = 0; j < 4; ++j) { int d = __builtin_amdgcn_cvt_pk_fp8_f32(sigmoidf_(acc[i][j][0]), sigmoidf_(acc[i][j][1]), 0, false); d = __builtin_amdgcn_cvt_pk_fp8_f32(sigmoidf_(acc[i][j][2]), sigmoidf_(acc[i][j][3]), d, true);
                    *(int*)(dst + (size_t)m * 1024 + c0 + 16 * j + 4 * _kg) = d; }
            }
        }
    }
}

static __device__ __forceinline__ void ph_kmean_egemm(CParams& p, int l, unsigned char* smem) {
    EPI_IDX;
    const int G = gridDim.x, vb = vblock();
    const bf16_t* ko = gptr((const bf16_t*)(p.ws + WS_K));
    float* kmean = gptr((float*)(p.ws + WS_KMEAN));
    float* red = (float*)smem;
    for (int u = vb; u < 512 + 128 + 256; u += G) {
        if (u >= 640) {
            const int e = u - 640, g = e >> 3, sl = e & 7, lg = l * 32 + g;
            float* s_km = (float*)smem;
            const float* km = gptr((const float*)(p.ws + WS_KM)) + (size_t)lg * 8192;
            __syncthreads();
            for (int idx = _t; idx < (4 * sl + 4) * 256; idx += NTHR) s_km[idx] = km[idx];
            __syncthreads();
            bf16_t* Tm = gptr((bf16_t*)(p.ws + WS_TM)) + (size_t)lg * 512 * 512;
            const float* dsk = gptr(p.d_skip) + l * 512 + g * 16;
            for (int ch = _t + sl * 4096; ch < (sl + 1) * 4096; ch += NTHR) {
                const int row = ch >> 6, c8 = ch & 63;
                const int i = row >> 4, c = row & 15, j = c8 >> 1, cb = (c8 & 1) * 8;
                if (j > ((i >> 3) << 3) + 7) continue;
                float v[8];
#pragma unroll
                for (int ee = 0; ee < 8; ++ee) {
                    float x = 0.f;
                    if (j <= i) { x = s_km[((i - j) * 16 + c) * 16 + cb + ee]; if (i == j && c == cb + ee) x += dsk[c]; }
                    v[ee] = x;
                }
                u32x4 o; o[0] = cvt_pk_bf16(v[0], v[1]); o[1] = cvt_pk_bf16(v[2], v[3]); o[2] = cvt_pk_bf16(v[4], v[5]); o[3] = cvt_pk_bf16(v[6], v[7]);
                *(u32x4*)(Tm + (size_t)row * 512 + c8 * 8) = o;
            }
        } else if (u < 512) {
            const int bh = u >> 5, j = u & 31, bb = bh >> 3, h = bh & 7;
            const int d = _t & 63, part = _t >> 6;
            float s = 0.f;
            const bf16_t* src = ko + ((size_t)(bb * S_ + j * 256 + part * 64)) * 512 + h * 64 + d;
            for (int i = 0; i < 64; ++i) s += bf2f(src[(size_t)i * 512]);
            __syncthreads();
            red[_t] = s;
            __syncthreads();
            if (_t < 64) kmean[(size_t)u * 64 + _t] = (red[_t] + red[64 + _t] + red[128 + _t] + red[192 + _t]) * (1.f / 256.f);
        } else {
            const int e = u - 512, g = e >> 2, mt = e & 3, m0 = mt * 128;
            const bf16_t* A = gptr((const bf16_t*)(p.ws + WS_UG)) + (size_t)g * T_ * 16;
            const bf16_t* Bt = gptr((const bf16_t*)(p.ws + WS_WE)) + (size_t)(l * 32 + g) * 128 * 512;
            f32x4 acc[4][4]; zero_acc(acc);
            __syncthreads();
            gemm_dd(acc, smem, A, 512, m0, Bt, 512, 0, 512 / 64);
            float* E = gptr((float*)(p.ws + WS_E)) + (size_t)g * 512 * 128;
#pragma unroll
            for (int i = 0; i < 4; ++i) {
                const int m = m0 + 64 * _wr + 16 * i + _l15;
#pragma unroll
                for (int j = 0; j < 4; ++j) *(f32x4*)(E + (size_t)m * 128 + 64 * _wc + 16 * j + 4 * _kg) = acc[i][j];
            }
        }
    }
}

static __device__ __forceinline__ void ph_gate_scan(CParams& p, int l, unsigned char* smem) {
    const int G = gridDim.x, vb = vblock(), t = otid();
    const bf16_t* qo = gptr((const bf16_t*)(p.ws + WS_Q));
    const float* kmean = gptr((const float*)(p.ws + WS_KMEAN));
    int* tot = gptr((int*)(p.ws + WS_CTL + CTL_TOT)) + l * 512 * TOS;
    unsigned short* list = gptr((unsigned short*)(p.ws + WS_LIST));
    float* lse = gptr((float*)(p.ws + WS_LSE));
    float* s_km = (float*)smem;
    int* s_cnt = (int*)(smem + 8192);
    int* s_base = (int*)(smem + 8192 + 128);
    float2* s_he = (float2*)(smem + 8192 + 256);
    for (int u = vb; u < 512 + 256; u += G) {
        __syncthreads();
        if (u < 512) {
            const int bh = u >> 5, qb = u & 31, bb = bh >> 3, h = bh & 7;
            for (int idx = t; idx < qb * 64; idx += NTHR) s_km[idx] = kmean[(size_t)(bh * 32) * 64 + idx];
            if (t < 32) s_cnt[t] = 0;
            __syncthreads();
            const int tok = bb * S_ + qb * 256 + t;
            float qv[64];
            {
                const u32x4* qp = (const u32x4*)(qo + (size_t)tok * 512 + h * 64);
#pragma unroll
                for (int c = 0; c < 8; ++c) { const u32x4 w = qp[c];
#pragma unroll
                    for (int e = 0; e < 4; ++e) { qv[c * 8 + 2 * e] = bflo(w[e]); qv[c * 8 + 2 * e + 1] = bfhi(w[e]); } }
            }
            float b0 = -3e38f, b1 = -3e38f, b2 = -3e38f; int i0 = 0, i1 = 0, i2 = 0;
            for (int j = 0; j < qb; ++j) {
                float g = 0.f;
#pragma unroll
                for (int d = 0; d < 64; ++d) g += qv[d] * s_km[j * 64 + d];
                if (g > b0) { b2 = b1; i2 = i1; b1 = b0; i1 = i0; b0 = g; i0 = j; }
                else if (g > b1) { b2 = b1; i2 = i1; b1 = g; i1 = j; }
                else if (g > b2) { b2 = g; i2 = j; }
            }
            const int nv = qb < 3 ? qb : 3;
            const int sel[3] = {i0, i1, i2};
            int pos[3];
#pragma unroll
            for (int s = 0; s < 3; ++s) {
                pos[s] = 0;
                if (s < nv) pos[s] = atomicAdd(&s_cnt[sel[s]], 1);
                else lse[((size_t)tok * 8 + h) * 4 + s] = NEG_INF;
            }
            __syncthreads();
            if (t < qb) { const int c = s_cnt[t]; s_base[t] = c > 0 ? atomicAdd(&tot[(t * 16 + bh) * TOS], c) : 0; }
            __syncthreads();
#pragma unroll
            for (int s = 0; s < 3; ++s)
                if (s < nv) list[(size_t)(bh * 32 + sel[s]) * 8192 + s_base[sel[s]] + pos[s]] = (unsigned short)((qb * 256 + t) | (s << 13));
        } else {
            const int e = u - 512, bb = e >> 7, g = (e >> 2) & 31, qr = e & 3, seg = t >> 4, nn = t & 15, n = qr * 16 + nn;
            const float* E = gptr((const float*)(p.ws + WS_E)) + ((size_t)g * 512 + bb * 256 + seg * 16) * 128;
            bf16_t* Hin = gptr((bf16_t*)(p.ws + WS_HIN)) + ((size_t)g * 512 + bb * 256 + seg * 16) * 128;
            const float2 a = (gptr((const float2*)(p.ws + WS_AL)))[(l * 32 + g) * 64 + n];
            float er[16], ei[16];
#pragma unroll
            for (int k = 0; k < 16; ++k) { er[k] = E[k * 128 + n]; ei[k] = E[k * 128 + 64 + n]; }
            float hr = 0.f, hi = 0.f;
#pragma unroll
            for (int k = 0; k < 16; ++k) { const float nr = a.x * hr - a.y * hi + er[k], ni = a.x * hi + a.y * hr + ei[k]; hr = nr; hi = ni; }
            s_he[seg * 16 + nn] = make_float2(hr, hi);
            float2 a16 = a;
#pragma unroll
            for (int k = 0; k < 4; ++k) a16 = make_float2(a16.x * a16.x - a16.y * a16.y, 2.f * a16.x * a16.y);
            __syncthreads();
            float cr = 0.f, ci = 0.f;
            for (int s = 0; s < seg; ++s) { const float2 he = s_he[s * 16 + nn]; const float nr = a16.x * cr - a16.y * ci + he.x, ni = a16.x * ci + a16.y * cr + he.y; cr = nr; ci = ni; }
            hr = cr; hi = ci;
#pragma unroll
            for (int k = 0; k < 16; ++k) {
                Hin[k * 128 + n] = f2bf(hr); Hin[k * 128 + 64 + n] = f2bf(hi);
                const float nr = a.x * hr - a.y * hi + er[k], ni = a.x * hi + a.y * hr + ei[k]; hr = nr; hi = ni;
            }
        }
    }
}

constexpr int AT_KS = 0;
constexpr int AT_VS = 32768;
constexpr int AT_UPRE = 32768 + 33280;
constexpr int AT_TOT = AT_UPRE + 2064;
constexpr int AT_MISC = AT_TOT + 2048;
constexpr int AT_NT = 8;

struct AttTile { int tok, slot, ql; bool valid; };

__device__ __forceinline__ void attn_unit(CParams& p, unsigned char* smem, int bh, int j, int sub, int nsel) {
    const int t = otid(), lane = t & 63, wid = t >> 6, l31 = lane & 31, hf = lane >> 5;
    const int bb = bh >> 3, h = bh & 7;
    const unsigned short* list = gptr((const unsigned short*)(p.ws + WS_LIST)) + (size_t)(bh * 32 + j) * 8192;
    const int ntiles = 8 + ((nsel + 31) >> 5);
    const int tile_lo = sub * AT_NT, tile_hi = (tile_lo + AT_NT < ntiles) ? tile_lo + AT_NT : ntiles;
    auto ent_load = [&](int tile) -> unsigned { if (tile < 8 || tile >= tile_hi) return 0u; const int idx = 32 * (tile - 8) + l31; return (unsigned)list[idx < nsel ? idx : 0]; };
    auto decode = [&](int tile, unsigned e) -> AttTile { AttTile a;
        if (tile < 8) { a.ql = 32 * tile + l31; a.tok = bb * S_ + j * 256 + a.ql; a.slot = 3; a.valid = true; }
        else { const int idx = 32 * (tile - 8) + l31; a.valid = (idx < nsel) && (tile < tile_hi); a.ql = 0; a.slot = (int)(e >> 13); a.tok = bb * S_ + (int)(e & 8191u); }
        return a; };
    const bf16_t* qg = gptr((const bf16_t*)(p.ws + WS_Q));
    const int tile0 = tile_lo + wid;
    unsigned e_a = ent_load(tile0), e_b = ent_load(tile0 + 4);
    {
        const bf16_t* ksrc = gptr((const bf16_t*)(p.ws + WS_K)) + ((size_t)(bb * S_ + j * 256)) * 512 + h * 64;
        u32x4 kv[8];
#pragma unroll
        for (int i = 0; i < 8; ++i) { const int idx = t + i * 256, row = idx >> 3, c = idx & 7; kv[i] = *(const u32x4*)(ksrc + (size_t)row * 512 + c * 8); }
        const bf16_t* vsrc = gptr((const bf16_t*)(p.ws + WS_VT)) + ((size_t)bh * 64) * S_ + j * 256;
        u32x4 vv[8];
#pragma unroll
        for (int i = 0; i < 8; ++i) { const int idx = t + i * 256, row = idx >> 5, c = idx & 31; vv[i] = *(const u32x4*)(vsrc + (size_t)row * S_ + c * 8); }
#pragma unroll
        for (int i = 0; i < 8; ++i) { const int idx = t + i * 256, row = idx >> 3, c = idx & 7; *(u32x4*)(smem + AT_KS + row * 128 + ((c ^ ((row >> 1) & 7)) << 4)) = kv[i]; }
#pragma unroll
        for (int i = 0; i < 8; ++i) { const int idx = t + i * 256, row = idx >> 5, c = idx & 31;
            u32x2 lo, hi2; lo[0] = vv[i][0]; lo[1] = vv[i][1]; hi2[0] = vv[i][2]; hi2[1] = vv[i][3];
            *(u32x2*)(smem + AT_VS + row * 520 + c * 16) = lo; *(u32x2*)(smem + AT_VS + row * 520 + c * 16 + 8) = hi2; }
    }
    AttTile cur = decode(tile0, e_a), nxt = decode(tile0 + 4, e_b);
    unsigned e_c = ent_load(tile0 + 8);
    bf16x8 qf[4];
#pragma unroll
    for (int s = 0; s < 4; ++s) qf[s] = *(const bf16x8*)(qg + (size_t)cur.tok * 512 + h * 64 + 16 * s + 8 * hf);
    __syncthreads();
    bf16_t* po = gptr((bf16_t*)(p.ws + WS_PO));
    float* lseo = gptr((float*)(p.ws + WS_LSE));
    for (int tile = tile0; tile < tile_hi; tile += 4) {
        bf16x8 qn[4];
#pragma unroll
        for (int s = 0; s < 4; ++s) qn[s] = *(const bf16x8*)(qg + (size_t)nxt.tok * 512 + h * 64 + 16 * s + 8 * hf);
        const unsigned e_d = ent_load(tile + 12);
        const bool own = tile < 8;
        const int ql = cur.ql;
        const int nkt = own ? tile + 1 : 8;
        f32x16 o0, o1;
#pragma unroll
        for (int r = 0; r < 16; ++r) { o0[r] = 0.f; o1[r] = 0.f; }
        float mrun = -3e38f, lrun = 0.f;
        for (int kt0 = 0; kt0 < nkt; kt0 += 2) {
            const bool has1 = (kt0 + 1 < nkt);
            f32x16 sacc[2];
#pragma unroll
            for (int kk = 0; kk < 2; ++kk) {
#pragma unroll
                for (int r = 0; r < 16; ++r) sacc[kk][r] = NEG_INF;
                if (kk == 0 || has1) {
                    f32x16 a;
#pragma unroll
                    for (int r = 0; r < 16; ++r) a[r] = 0.f;
                    const int krow = 32 * (kt0 + kk) + l31;
#pragma unroll
                    for (int s = 0; s < 4; ++s) {
                        const bf16x8 kf = *(const bf16x8*)(smem + AT_KS + krow * 128 + (((2 * s + hf) ^ ((krow >> 1) & 7)) << 4));
                        a = __builtin_amdgcn_mfma_f32_32x32x16_bf16(kf, qf[s], a, 0, 0, 0);
                    }
                    if (own) {
#pragma unroll
                        for (int r = 0; r < 16; ++r) { const int key = 32 * (kt0 + kk) + (r & 3) + 8 * (r >> 2) + 4 * hf; if (key > ql) a[r] = NEG_INF; }
                    }
                    sacc[kk] = a;
                }
            }
            float mx = mrun;
#pragma unroll
            for (int kk = 0; kk < 2; ++kk)
#pragma unroll
                for (int r = 0; r < 16; ++r) mx = fmaxf(mx, sacc[kk][r]);
            mx = fmaxf(mx, __shfl_xor(mx, 32));
            const float corr = __expf(mrun - mx);
            lrun *= corr;
#pragma unroll
            for (int r = 0; r < 16; ++r) { o0[r] *= corr; o1[r] *= corr; }
            mrun = mx;
#pragma unroll
            for (int kk = 0; kk < 2; ++kk) {
                if (kk == 0 || has1) {
                    float pv[16];
#pragma unroll
                    for (int r = 0; r < 16; ++r) { pv[r] = __expf(sacc[kk][r] - mx); lrun += pv[r]; }
#pragma unroll
                    for (int s = 0; s < 2; ++s) {
                        union { bf16x8 v; unsigned w[4]; } pf;
                        pf.w[0] = cvt_pk_bf16(pv[8 * s + 0], pv[8 * s + 1]); pf.w[1] = cvt_pk_bf16(pv[8 * s + 2], pv[8 * s + 3]);
                        pf.w[2] = cvt_pk_bf16(pv[8 * s + 4], pv[8 * s + 5]); pf.w[3] = cvt_pk_bf16(pv[8 * s + 6], pv[8 * s + 7]);
                        const int key0 = 32 * (kt0 + kk) + 16 * s + 4 * hf;
#pragma unroll
                        for (int dt = 0; dt < 2; ++dt) {
                            const unsigned char* vp = smem + AT_VS + (32 * dt + l31) * 520 + key0 * 2;
                            union { bf16x8 v; u32x2 h2[2]; } vf;
                            vf.h2[0] = *(const u32x2*)vp; vf.h2[1] = *(const u32x2*)(vp + 16);
                            if (dt == 0) o0 = __builtin_amdgcn_mfma_f32_32x32x16_bf16(vf.v, pf.v, o0, 0, 0, 0);
                            else o1 = __builtin_amdgcn_mfma_f32_32x32x16_bf16(vf.v, pf.v, o1, 0, 0, 0);
                        }
                    }
                }
            }
        }
        const float ltot = lrun + __shfl_xor(lrun, 32);
        const float inv = 1.f / ltot;
        if (cur.valid) {
            bf16_t* dst = po + (((size_t)cur.tok * 8 + h) * 4 + cur.slot) * 64;
#pragma unroll
            for (int g4 = 0; g4 < 4; ++g4) {
                st_bf16x4(dst + 8 * g4 + 4 * hf, o0[4 * g4] * inv, o0[4 * g4 + 1] * inv, o0[4 * g4 + 2] * inv, o0[4 * g4 + 3] * inv);
                st_bf16x4(dst + 32 + 8 * g4 + 4 * hf, o1[4 * g4] * inv, o1[4 * g4 + 1] * inv, o1[4 * g4 + 2] * inv, o1[4 * g4 + 3] * inv);
            }
            if (hf == 0) lseo[((size_t)cur.tok * 8 + h) * 4 + cur.slot] = mrun + __logf(ltot);
        }
        cur = nxt; nxt = decode(tile + 8, e_c); e_c = e_d;
#pragma unroll
        for (int s = 0; s < 4; ++s) qf[s] = qn[s];
    }
}

static __device__ __forceinline__ void ph_attn_ygemm(CParams& p, int l, unsigned char* smem) {
    EPI_IDX;
    const int G = gridDim.x, vb = vblock();
    for (int u = vb; u < 512; u += G) {
        const int g = u >> 4, mt = (u >> 2) & 3, nt = u & 3, m0 = mt * 128, n0 = nt * 128;
        const bf16_t* A1 = gptr((const bf16_t*)(p.ws + WS_UG)) + (size_t)g * T_ * 16;
        const bf16_t* B1 = gptr((const bf16_t*)(p.ws + WS_TM)) + (size_t)(l * 32 + g) * 512 * 512;
        const bf16_t* A2 = gptr((const bf16_t*)(p.ws + WS_HIN)) + (size_t)g * 512 * 128;
        const bf16_t* B2 = gptr((const bf16_t*)(p.ws + WS_WC)) + (size_t)(l * 32 + g) * 512 * 128;
        f32x4 acc[4][4]; zero_acc(acc);
        __syncthreads();
        gemm_dd(acc, smem, A1, 512, m0, B1, 512, n0, 2 * (nt + 1));
        gemm_dd(acc, smem, A2, 128, m0, B2, 128, n0, 2);
        bf16_t* z = gptr((bf16_t*)(p.ws + WS_Z));
#pragma unroll
        for (int i = 0; i < 4; ++i) {
            const int m = m0 + 64 * _wr + 16 * i + _l15;
#pragma unroll
            for (int j = 0; j < 4; ++j) {
                const int n = n0 + 64 * _wc + 16 * j, ii = n >> 4;
                st_bf16x4(z + (size_t)(32 * m + ii) * 512 + g * 16 + 4 * _kg, gelu_tanh(acc[i][j][0]), gelu_tanh(acc[i][j][1]), gelu_tanh(acc[i][j][2]), gelu_tanh(acc[i][j][3]));
            }
        }
    }
    int* s_upre = (int*)(smem + AT_UPRE); int* s_tot = (int*)(smem + AT_TOT); int* s_u = (int*)(smem + AT_MISC);
    const int* tot = gptr((const int*)(p.ws + WS_CTL + CTL_TOT)) + l * 512 * TOS;
    __syncthreads();
    for (int i = _t; i < 512; i += NTHR) { const int c = tot[i * TOS]; s_tot[i] = c; s_upre[i] = (8 + ((c + 31) >> 5) + AT_NT - 1) / AT_NT; }
    __syncthreads();
    if (_t == 0) { int run = 0; for (int i = 0; i < 512; ++i) { const int v = s_upre[i]; s_upre[i] = run; run += v; } s_upre[512] = run; }
    __syncthreads();
    const int total = s_upre[512];
    int* qctr = gptr((int*)(p.ws + WS_CTL + CTL_ATTQ + 256 * l));
    for (;;) {
        __syncthreads();
        if (_t == 0) *s_u = atomicAdd(qctr, 1);
        __syncthreads();
        const int u = *s_u;
        if (u >= total) break;
        int lo = 0, hi = 511;
        while (lo < hi) { const int mid = (lo + hi + 1) >> 1; if (s_upre[mid] <= u) lo = mid; else hi = mid - 1; }
        attn_unit(p, smem, lo & 15, lo >> 4, u - s_upre[lo], s_tot[lo]);
    }
}

static __device__ __forceinline__ void ph_combine_glu(CParams& p, int l, unsigned char* smem) {
    EPI_IDX;
    const int G = gridDim.x, vb = vblock();
    {
        const float* lse = gptr((const float*)(p.ws + WS_LSE)); const bf16_t* po = gptr((const bf16_t*)(p.ws + WS_PO)); bf16_t* ao = gptr((bf16_t*)(p.ws + WS_AO));
        for (int idx = obid() * NTHR + _t; idx < T_ * 8 * 8; idx += G * NTHR) {
            const int th = idx >> 3, c = idx & 7;
            const f32x4 ls = *(const f32x4*)(lse + (size_t)th * 4);
            const float mx = fmaxf(fmaxf(ls[0], ls[1]), fmaxf(ls[2], ls[3]));
            float w[4], ws = 0.f;
#pragma unroll
            for (int s = 0; s < 4; ++s) { w[s] = (ls[s] > -1e29f) ? __expf(ls[s] - mx) : 0.f; ws += w[s]; }
            const float inv = 1.f / ws;
            float o[8];
#pragma unroll
            for (int e = 0; e < 8; ++e) o[e] = 0.f;
#pragma unroll
            for (int s = 0; s < 4; ++s) {
                if (w[s] > 0.f) {
                    const u32x4 v = *(const u32x4*)(po + ((size_t)th * 4 + s) * 64 + c * 8);
                    const float ww = w[s] * inv;
#pragma unroll
                    for (int e = 0; e < 4; ++e) { o[2 * e] += ww * bflo(v[e]); o[2 * e + 1] += ww * bfhi(v[e]); }
                }
            }
            u32x4 ov; ov[0] = cvt_pk_bf16(o[0], o[1]); ov[1] = cvt_pk_bf16(o[2], o[3]); ov[2] = cvt_pk_bf16(o[4], o[5]); ov[3] = cvt_pk_bf16(o[6], o[7]);
            *(u32x4*)(ao + (size_t)th * 64 + c * 8) = ov;
        }
    }
    const bf16_t* z = gptr((const bf16_t*)(p.ws + WS_Z));
    const bf16_t* Wt = gptr((const bf16_t*)(p.ws + WS_WG)) + (size_t)l * 512 * 512; const float* bg = gptr(p.b_glu) + l * 512;
    bf16_t* sgl = gptr((bf16_t*)(p.ws + WS_SGL));
    TileSched ts; ts.init(vb, G, 4);
    for (int u = ts.rank; u < ts.U; u += ts.R) {
        int mt, nt; ts.get(u, mt, nt);
        const int m0 = mt * 128, n0 = nt * 128;
        f32x4 acc[4][4]; zero_acc(acc);
        __syncthreads();
        gemm_dd(acc, smem, z, 512, m0, Wt, 512, n0, 8);
#pragma unroll
        for (int i = 0; i < 4; ++i) {
            const int m = m0 + 64 * _wr + 16 * i + _l15;
#pragma unroll
            for (int j = 0; j < 4; ++j) {
                const int n = n0 + 64 * _wc + 16 * j + 4 * _kg;
                const u32x2 zz = *(const u32x2*)(z + (size_t)m * 512 + n);
                const f32x4 bv = *(const f32x4*)(bg + n);
                const float z0 = bflo(zz[0]), z1 = bfhi(zz[0]), z2 = bflo(zz[1]), z3 = bfhi(zz[1]);
                st_bf16x4(sgl + (size_t)m * 512 + n, z0 * sigmoidf_(acc[i][j][0] + bv[0]), z1 * sigmoidf_(acc[i][j][1] + bv[1]), z2 * sigmoidf_(acc[i][j][2] + bv[2]), z3 * sigmoidf_(acc[i][j][3] + bv[3]));
            }
        }
    }
}

static __device__ __forceinline__ void ph_merge(CParams& p, int l, unsigned char* smem) {
    EPI_IDX;
    const int G = gridDim.x, vb = vblock();
    const bf16_t* ao = gptr((const bf16_t*)(p.ws + WS_AO)); const bf16_t* sgl = gptr((const bf16_t*)(p.ws + WS_SGL));
    const unsigned char* ga = gptr((const unsigned char*)(p.ws + WS_GA)); const unsigned char* gs = gptr((const unsigned char*)(p.ws + WS_GS));
    const bf16_t* Wa = gptr((const bf16_t*)(p.ws + WS_WA)) + (size_t)l * 1024 * 512; const bf16_t* Ws = gptr((const bf16_t*)(p.ws + WS_WSU)) + (size_t)l * 1024 * 512;
    bf16_t* mix = gptr((bf16_t*)(p.ws + WS_MIX));
    TileSched ts; ts.init(vb, G, 8);
    for (int u = ts.rank; u < ts.U; u += ts.R) {
        int mt, nt; ts.get(u, mt, nt);
        const int m0 = mt * 128, n0 = nt * 128;
        unsigned pa[4][4][2];
        {
            f32x4 acca[4][4]; zero_acc(acca);
            __syncthreads();
            gemm_dd(acca, smem, ao, 512, m0, Wa, 512, n0, 8);
#pragma unroll
            for (int i = 0; i < 4; ++i) {
                const int m = m0 + 64 * _wr + 16 * i + _l15;
#pragma unroll
                for (int j = 0; j < 4; ++j) {
                    const int n = n0 + 64 * _wc + 16 * j + 4 * _kg;
                    const int a4 = *(const int*)(ga + (size_t)m * 1024 + n);
                    const f32x2v alo = __builtin_amdgcn_cvt_pk_f32_fp8(a4, false), ahi = __builtin_amdgcn_cvt_pk_f32_fp8(a4, true);
                    pa[i][j][0] = cvt_pk_bf16(alo[0] * acca[i][j][0], alo[1] * acca[i][j][1]);
                    pa[i][j][1] = cvt_pk_bf16(ahi[0] * acca[i][j][2], ahi[1] * acca[i][j][3]);
                }
            }
        }
        f32x4 accs[4][4]; zero_acc(accs);
        gemm_dd(accs, smem, sgl, 512, m0, Ws, 512, n0, 8);
#pragma unroll
        for (int i = 0; i < 4; ++i) {
            const int m = m0 + 64 * _wr + 16 * i + _l15;
#pragma unroll
            for (int j = 0; j < 4; ++j) {
                const int n = n0 + 64 * _wc + 16 * j + 4 * _kg;
                const int s4 = *(const int*)(gs + (size_t)m * 1024 + n);
                const f32x2v slo = __builtin_amdgcn_cvt_pk_f32_fp8(s4, false), shi = __builtin_amdgcn_cvt_pk_f32_fp8(s4, true);
                st_bf16x4(mix + (size_t)m * 1024 + n,
                          bflo(pa[i][j][0]) + slo[0] * accs[i][j][0], bfhi(pa[i][j][0]) + slo[1] * accs[i][j][1],
                          bflo(pa[i][j][1]) + shi[0] * accs[i][j][2], bfhi(pa[i][j][1]) + shi[1] * accs[i][j][3]);
            }
        }
    }
}

static __device__ __forceinline__ void ph_outproj(CParams& p, int l, unsigned char* smem) {
    EPI_IDX;
    const int G = gridDim.x, vb = vblock();
    const bf16_t* mix = gptr((const bf16_t*)(p.ws + WS_MIX));
    const bf16_t* Wt = gptr((const bf16_t*)(p.ws + WS_WO)) + (size_t)l * 1024 * 1024;
    const bf16_t* xres = gptr((const bf16_t*)(p.ws + WS_XB));
    bf16_t* y1 = gptr((bf16_t*)(p.ws + WS_Y1));
    unsigned long long* pst = gptr((unsigned long long*)(p.ws + WS_PST)) + (size_t)l * T_ * 16;
    unsigned* pcnt = gptr((unsigned*)(p.ws + WS_CTL + CTL_PCNT)) + l * 128 * 16;
    TileSched ts; ts.init(vb, G, 8);
    int pend = -1;
    for (int u = ts.rank; u < ts.U; u += ts.R) {
        int mt, nt; ts.get(u, mt, nt);
        const int m0 = mt * 128, n0 = nt * 128;
        f32x4 acc[4][4]; zero_acc(acc);
        __syncthreads();
        gemm_dd(acc, smem, mix, 1024, m0, Wt, 1024, n0, 16);
        if (pend >= 0) { asm volatile("s_waitcnt vmcnt(0)" ::: "memory"); if (_lane == 0) (void)xb_add(pcnt + pend * 16, 1u); }
#pragma unroll
        for (int i = 0; i < 4; ++i) {
            const int m = m0 + 64 * _wr + 16 * i + _l15;
            float s = 0.f, q = 0.f;
#pragma unroll
            for (int j = 0; j < 4; ++j) {
                const int n = n0 + 64 * _wc + 16 * j + 4 * _kg;
                const u32x2 xr = *(const u32x2*)(xres + (size_t)m * 1024 + n);
                u32x2 v; v[0] = cvt_pk_bf16(bflo(xr[0]) * DN_ALPHA + acc[i][j][0], bfhi(xr[0]) * DN_ALPHA + acc[i][j][1]); v[1] = cvt_pk_bf16(bflo(xr[1]) * DN_ALPHA + acc[i][j][2], bfhi(xr[1]) * DN_ALPHA + acc[i][j][3]);
                *(u32x2*)(y1 + (size_t)m * 1024 + n) = v;
                const float r0 = bflo(v[0]), r1 = bfhi(v[0]), r2 = bflo(v[1]), r3 = bfhi(v[1]);
                s += (r0 + r1) + (r2 + r3); q += (r0 * r0 + r1 * r1) + (r2 * r2 + r3 * r3);
            }
            s += __shfl_xor(s, 16); q += __shfl_xor(q, 16); s += __shfl_xor(s, 32); q += __shfl_xor(q, 32);
            if (_kg == 0) __hip_atomic_store(pst + (size_t)m * 16 + nt * 2 + _wc, ((unsigned long long)__float_as_uint(q) << 32) | __float_as_uint(s), __ATOMIC_RELAXED, __HIP_MEMORY_SCOPE_AGENT);
        }
        pend = mt;
    }
    if (pend >= 0) { asm volatile("s_waitcnt vmcnt(0)" ::: "memory"); if (_lane == 0) (void)xb_add(pcnt + pend * 16, 1u); }
    const float* gam = gptr(p.ln1_g) + l * 1024; const float* bet = gptr(p.ln1_b) + l * 1024;
    bf16_t* x1b = gptr((bf16_t*)(p.ws + WS_X1B));
    float2* s_st = (float2*)smem;
    for (int u = ts.rank; u < ts.U; u += ts.R) {
        int mt, nt; ts.get(u, mt, nt);
        const int m0 = mt * 128, n0 = nt * 128;
        __syncthreads();
        if (_wid == 0) {
            if (_lane == 0) { unsigned sp = 0u; while (xb_ld(pcnt + mt * 16) < 32u) { __builtin_amdgcn_s_sleep(1); if (++sp > XB_SPIN_CAP) break; } }
            __builtin_amdgcn_fence(__ATOMIC_ACQUIRE, "agent");
        }
        asm volatile("s_waitcnt vmcnt(0)" ::: "memory");
        __syncthreads();
        {
            const int r = _t >> 1, hf = _t & 1;
            float s = 0.f, q = 0.f;
#pragma unroll
            for (int k = 0; k < 8; ++k) { const unsigned long long g = __hip_atomic_load(pst + (size_t)(m0 + r) * 16 + hf * 8 + k, __ATOMIC_RELAXED, __HIP_MEMORY_SCOPE_AGENT);
                s += __uint_as_float((unsigned)g); q += __uint_as_float((unsigned)(g >> 32)); }
            s += __shfl_xor(s, 1); q += __shfl_xor(q, 1);
            const float mu = s * (1.f / 1024.f), var = fmaxf(q * (1.f / 1024.f) - mu * mu, 0.f);
            if (hf == 0) s_st[r] = make_float2(mu, rsqrtf(var + LN_EPS));
        }
        __syncthreads();
        const int c8 = (_t & 15) * 8, r0 = _t >> 4;
        const f32x4 g0 = *(const f32x4*)(gam + n0 + c8), g1 = *(const f32x4*)(gam + n0 + c8 + 4), b0 = *(const f32x4*)(bet + n0 + c8), b1 = *(const f32x4*)(bet + n0 + c8 + 4);
#pragma unroll
        for (int k = 0; k < 8; ++k) {
            const int r = r0 + 16 * k;
            const u32x4 x = *(const u32x4*)(y1 + (size_t)(m0 + r) * 1024 + n0 + c8);
            const float2 st = s_st[r];
            u32x4 w;
            w[0] = cvt_pk_bf16((bflo(x[0]) - st.x) * st.y * g0[0] + b0[0], (bfhi(x[0]) - st.x) * st.y * g0[1] + b0[1]);
            w[1] = cvt_pk_bf16((bflo(x[1]) - st.x) * st.y * g0[2] + b0[2], (bfhi(x[1]) - st.x) * st.y * g0[3] + b0[3]);
            w[2] = cvt_pk_bf16((bflo(x[2]) - st.x) * st.y * g1[0] + b1[0], (bfhi(x[2]) - st.x) * st.y * g1[1] + b1[1]);
            w[3] = cvt_pk_bf16((bflo(x[3]) - st.x) * st.y * g1[2] + b1[2], (bfhi(x[3]) - st.x) * st.y * g1[3] + b1[3]);
            *(u32x4*)(x1b + (size_t)(m0 + r) * 1024 + n0 + c8) = w;
        }
    }
}

template <bool MOE>
static __device__ __forceinline__ void ph_layernorm(CParams& p, const bf16_t* src, const float* gam, const float* bet, float* dstf, bf16_t* dstb) {
    const int G = gridDim.x, t = otid(), lane = t & 63, wid = t >> 6;
    const unsigned char* yb = gptr((const unsigned char*)(p.ws + WS_YBUF));
    for (int row = obid() * 4 + wid; row < T_; row += G * 4) {
        float v[16];
#pragma unroll
        for (int c = 0; c < 2; ++c) { const u32x4 x = *(const u32x4*)(src + (size_t)row * 1024 + c * 512 + lane * 8);
#pragma unroll
            for (int e = 0; e < 4; ++e) { v[8 * c + 2 * e] = bflo(x[e]); v[8 * c + 2 * e + 1] = bfhi(x[e]); } }
        if (MOE) {
#pragma unroll
            for (int k = 0; k < 8; ++k)
#pragma unroll
                for (int c = 0; c < 2; ++c) { const u32x2 y = *(const u32x2*)(yb + ((size_t)row * 8 + k) * 1024 + c * 512 + lane * 8);
#pragma unroll
                    for (int e = 0; e < 2; ++e) { const f32x2v lo = __builtin_amdgcn_cvt_pk_f32_bf8((int)y[e], false), hi = __builtin_amdgcn_cvt_pk_f32_bf8((int)y[e], true);
                        v[8 * c + 4 * e] += lo[0]; v[8 * c + 4 * e + 1] += lo[1]; v[8 * c + 4 * e + 2] += hi[0]; v[8 * c + 4 * e + 3] += hi[1]; } }
        }
        float s = 0.f;
#pragma unroll
        for (int e = 0; e < 16; ++e) s += v[e];
#pragma unroll
        for (int o = 32; o >= 1; o >>= 1) s += __shfl_xor(s, o);
        const float mu = s * (1.f / 1024.f);
        float q = 0.f;
#pragma unroll
        for (int e = 0; e < 16; ++e) { v[e] -= mu; q += v[e] * v[e]; }
#pragma unroll
        for (int o = 32; o >= 1; o >>= 1) q += __shfl_xor(q, o);
        const float rs = rsqrtf(q * (1.f / 1024.f) + LN_EPS);
#pragma unroll
        for (int c = 0; c < 2; ++c) {
            float o[8];
#pragma unroll
            for (int h = 0; h < 2; ++h) { const f32x4 gg = *(const f32x4*)(gam + c * 512 + lane * 8 + 4 * h), bb = *(const f32x4*)(bet + c * 512 + lane * 8 + 4 * h);
#pragma unroll
                for (int e = 0; e < 4; ++e) o[4 * h + e] = v[8 * c + 4 * h + e] * rs * gg[e] + bb[e]; }
            if (dstf) { *(f32x4*)(dstf + (size_t)row * 1024 + c * 512 + lane * 8) = (f32x4){o[0], o[1], o[2], o[3]}; *(f32x4*)(dstf + (size_t)row * 1024 + c * 512 + lane * 8 + 4) = (f32x4){o[4], o[5], o[6], o[7]}; }
            if (dstb) { u32x4 w; w[0] = cvt_pk_bf16(o[0], o[1]); w[1] = cvt_pk_bf16(o[2], o[3]); w[2] = cvt_pk_bf16(o[4], o[5]); w[3] = cvt_pk_bf16(o[6], o[7]); *(u32x4*)(dstb + (size_t)row * 1024 + c * 512 + lane * 8) = w; }
        }
    }
}

static __device__ __forceinline__ void ph_router_shared1(CParams& p, int l, unsigned char* smem) {
    EPI_IDX;
    const int G = gridDim.x, vb = vblock();
    const bf16_t* x1b = gptr((const bf16_t*)(p.ws + WS_X1B));
    const bf16_t* Wt = gptr((const bf16_t*)(p.ws + WS_WRS)) + (size_t)l * 768 * 1024;
    TileSched ts; ts.init(vb, G, 6);
    for (int u = ts.rank; u < ts.U; u += ts.R) {
        int mt, nt; ts.get(u, mt, nt);
        const int m0 = mt * 128, n0 = nt * 128;
        f32x4 acc[4][4]; zero_acc(acc);
        __syncthreads();
        gemm_dd(acc, smem, x1b, 1024, m0, Wt, 1024, n0, 16);
        if (nt < 2) {
            float* sc = gptr((float*)(p.ws + WS_SC));
#pragma unroll
            for (int i = 0; i < 4; ++i) {
                const int m = m0 + 64 * _wr + 16 * i + _l15;
#pragma unroll
                for (int j = 0; j < 4; ++j) { f32x4 o; o[0] = sigmoidf_(acc[i][j][0]); o[1] = sigmoidf_(acc[i][j][1]); o[2] = sigmoidf_(acc[i][j][2]); o[3] = sigmoidf_(acc[i][j][3]);
                    *(f32x4*)(sc + (size_t)m * 256 + n0 + 64 * _wc + 16 * j + 4 * _kg) = o; }
            }
        } else {
            const int c0 = (nt - 2) * 64;
            bf16_t* hs = gptr((bf16_t*)(p.ws + WS_HS));
#pragma unroll
            for (int i = 0; i < 4; ++i) {
                const int m = m0 + 64 * _wr + 16 * i + _l15;
#pragma unroll
                for (int j = 0; j < 2; ++j)
                    st_bf16x4(hs + (size_t)m * 256 + c0 + 32 * _wc + 16 * j + 4 * _kg, siluf_(acc[i][j][0]) * acc[i][j + 2][0], siluf_(acc[i][j][1]) * acc[i][j + 2][1], siluf_(acc[i][j][2]) * acc[i][j + 2][2], siluf_(acc[i][j][3]) * acc[i][j + 2][3]);
            }
        }
    }
}

static __device__ __forceinline__ void ph_route_shared2(CParams& p, int l, unsigned char* smem) {
    EPI_IDX;
    const int G = gridDim.x, vb = vblock();
    int* s_ae = (int*)smem;
    float* s_aw = (float*)(smem + 1024);
    int* ecnt = gptr((int*)(p.ws + WS_CTL + CTL_ECNT)) + l * 256 * ECS;
    int2* rowl = gptr((int2*)(p.ws + WS_ROWL));
    const float* sc = gptr((const float*)(p.ws + WS_SC));
    const float* rb = gptr(p.router_bias) + l * 256;
    for (int u = vb; u < 512 + 1024; u += G) {
        if (u < 512) {
            __syncthreads();
            const unsigned long long lt_mask = (1ull << _lane) - 1ull;
            for (int it = 0; it < 8; ++it) {
                const int tl = _wid * 8 + it, tok = u * 32 + tl;
                const f32x4 s4 = *(const f32x4*)(sc + (size_t)tok * 256 + _lane * 4);
                const f32x4 b4 = *(const f32x4*)(rb + _lane * 4);
                float bs[4] = {s4[0] + b4[0], s4[1] + b4[1], s4[2] + b4[2], s4[3] + b4[3]};
                float m1 = fmaxf(bs[0], bs[1]), m2 = fminf(bs[0], bs[1]);
                { const float v = bs[2]; if (v > m1) { m2 = m1; m1 = v; } else if (v > m2) m2 = v; }
                { const float v = bs[3]; if (v > m1) { m2 = m1; m1 = v; } else if (v > m2) m2 = v; }
#pragma unroll
                for (int o = 1; o <= 4; o <<= 1) { const float o1 = __shfl_xor(m1, o), o2 = __shfl_xor(m2, o); const float n1 = fmaxf(m1, o1), n2 = fmaxf(fminf(m1, o1), fmaxf(m2, o2)); m1 = n1; m2 = n2; }
                const float gsc = m1 + m2; const int mygrp = _lane >> 3;
                int rank = 0;
#pragma unroll
                for (int g2 = 0; g2 < 8; ++g2) { const float og = __int_as_float(__builtin_amdgcn_readlane(__float_as_int(gsc), g2 * 8)); rank += (og > gsc || (og == gsc && g2 < mygrp)) ? 1 : 0; }
                const bool gsel = rank < 4;
                unsigned key[4];
#pragma unroll
                for (int e = 0; e < 4; ++e) { const unsigned bits = __float_as_uint(bs[e]); key[e] = gsel ? (bits ^ ((bits >> 31) ? 0xFFFFFFFFu : 0x80000000u)) : 0u; }
                unsigned T = 0u;
                for (int bit = 31; bit >= 0; --bit) {
                    const unsigned cand = T | (1u << bit);
                    int c = 0;
#pragma unroll
                    for (int e = 0; e < 4; ++e) c += __popcll(__ballot(key[e] >= cand));
                    if (c >= 8) T = cand;
                }
                int ngt = 0;
#pragma unroll
                for (int e = 0; e < 4; ++e) ngt += __popcll(__ballot(key[e] > T));
                unsigned long long beq[4];
#pragma unroll
                for (int e = 0; e < 4; ++e) beq[e] = __ballot(key[e] == T);
                int eq_before = 0;
#pragma unroll
                for (int e = 0; e < 4; ++e) eq_before += __popcll(beq[e] & lt_mask);
                bool sel[4]; int eqm = 0;
#pragma unroll
                for (int e = 0; e < 4; ++e) { const bool isgt = key[e] > T, iseq = key[e] == T; sel[e] = isgt || (iseq && (ngt + eq_before + eqm < 8)); eqm += iseq ? 1 : 0; }
                unsigned long long bsel[4];
#pragma unroll
                for (int e = 0; e < 4; ++e) bsel[e] = __ballot(sel[e]);
                int kidx = 0;
#pragma unroll
                for (int e = 0; e < 4; ++e) kidx += __popcll(bsel[e] & lt_mask);
#pragma unroll
                for (int e = 0; e < 4; ++e) if (sel[e]) { s_ae[tl * 8 + kidx] = _lane * 4 + e; s_aw[tl * 8 + kidx] = s4[e]; ++kidx; }
            }
            __syncthreads();
            {
                const int a = _t, tl = a >> 3, e = s_ae[a];
                float wsum = 0.f;
#pragma unroll
                for (int k = 0; k < 8; ++k) wsum += s_aw[tl * 8 + k];
                const float w = s_aw[a] / wsum * 2.5f;
                const int pos = atomicAdd(&ecnt[e * ECS], 1);
                rowl[(size_t)e * 16384 + pos] = make_int2((u * 32 + tl) * 8 + (a & 7), __float_as_int(w));
            }
        } else {
            const int e = u - 512, mt = e >> 3, nt = e & 7, m0 = mt * 128, n0 = nt * 128;
            const bf16_t* hs = gptr((const bf16_t*)(p.ws + WS_HS));
            const bf16_t* Wt = gptr((const bf16_t*)(p.ws + WS_WSD)) + (size_t)l * 1024 * 256;
            f32x4 acc[4][4]; zero_acc(acc);
            __syncthreads();
            gemm_dd(acc, smem, hs, 256, m0, Wt, 256, n0, 4);
            const bf16_t* x1r = gptr((const bf16_t*)(p.ws + WS_X1B)); bf16_t* y2 = gptr((bf16_t*)(p.ws + WS_Y1));
#pragma unroll
            for (int i = 0; i < 4; ++i) {
                const int m = m0 + 64 * _wr + 16 * i + _l15;
#pragma unroll
                for (int j = 0; j < 4; ++j) {
                    const int n = n0 + 64 * _wc + 16 * j + 4 * _kg;
                    const u32x2 xr = *(const u32x2*)(x1r + (size_t)m * 1024 + n);
                    st_bf16x4(y2 + (size_t)m * 1024 + n, bflo(xr[0]) * DN_ALPHA + acc[i][j][0], bfhi(xr[0]) * DN_ALPHA + acc[i][j][1], bflo(xr[1]) * DN_ALPHA + acc[i][j][2], bfhi(xr[1]) * DN_ALPHA + acc[i][j][3]);
                }
            }
        }
    }
}

struct ExpPre { int mypre, total; };
__device__ __forceinline__ ExpPre expert_prefix(const int* ecnt, unsigned char* smem, int ntile_per_rb, int rows_per_unit) {
    const int t = otid(), lane = t & 63, wid = t >> 6;
    int* sx = (int*)smem;
    const int c = ecnt[t * ECS];
    const int v = ((c + rows_per_unit - 1) / rows_per_unit) * ntile_per_rb;
    int inc = v;
#pragma unroll
    for (int o = 1; o < 64; o <<= 1) { const int y = __shfl_up(inc, o); if (lane >= o) inc += y; }
    __syncthreads();
    if (lane == 63) sx[wid] = inc;
    __syncthreads();
    const int t0 = sx[0], t1 = sx[1], t2 = sx[2], t3 = sx[3];
    ExpPre r; r.mypre = inc - v + (wid > 0 ? t0 : 0) + (wid > 1 ? t1 : 0) + (wid > 2 ? t2 : 0); r.total = t0 + t1 + t2 + t3;
    __syncthreads();
    return r;
}
__device__ __forceinline__ void expert_find(const ExpPre& ep, unsigned char* smem, int u, int& e, int& start) {
    const int t = otid(), lane = t & 63, wid = t >> 6;
    int* sx = (int*)smem;
    const int cw = __popcll(__ballot(ep.mypre <= u));
    const int sw_ = __shfl(ep.mypre, cw > 0 ? cw - 1 : 0);
    __syncthreads();
    if (lane == 0) { sx[2 * wid] = cw; sx[2 * wid + 1] = cw > 0 ? sw_ : -1; }
    __syncthreads();
    const int c0 = sx[0], c1 = sx[2], c2 = sx[4], c3 = sx[6];
    e = __builtin_amdgcn_readfirstlane(c0 + c1 + c2 + c3 - 1);
    int s = sx[1]; s = sx[3] > s ? sx[3] : s; s = sx[5] > s ? sx[5] : s; s = sx[7] > s ? sx[7] : s;
    start = __builtin_amdgcn_readfirstlane(s);
    __syncthreads();
}

static __device__ __forceinline__ void ph_expert1(CParams& p, int l, unsigned char* smem) {
    EPI_IDX;
    const int G = gridDim.x, vb = vblock();
    const int* ecnt = gptr((const int*)(p.ws + WS_CTL + CTL_ECNT)) + l * 256 * ECS;
    const ExpPre ep = expert_prefix(ecnt, smem, 4, 256);
    const int total = ep.total;
    const int2* rowl = gptr((const int2*)(p.ws + WS_ROWL));
    const bf16_t* x1b = gptr((const bf16_t*)(p.ws + WS_X1B));
    bf16_t* hb = gptr((bf16_t*)(p.ws + WS_HBUF));
    for (int u = vb; u < total; u += G) {
        int e, ustart; expert_find(ep, smem, u, e, ustart);
        const int cnt = __builtin_amdgcn_readfirstlane(ecnt[e * ECS]), npr = (cnt + 255) >> 8, r = u - ustart, nt = r / npr, pr = r % npr, c0 = nt * 64;
        const int2* rl = rowl + (size_t)e * 16384 + pr * 256;
        const int nrows = cnt - pr * 256;
        const bool has1 = nrows > 128;
        f32x4 acc0[4][4], acc1[4][4]; zero_acc(acc0); zero_acc(acc1);
        unsigned ap0[4], ap1[4];
#pragma unroll
        for (int q = 0; q < 4; ++q) { int rr = dma_row(_t, q); int r0 = rr < nrows ? rr : 0, r1 = 128 + rr < nrows ? 128 + rr : 0;
            const int a0 = rl[r0].x, a1 = rl[r1].x; ap0[q] = (unsigned)(a0 >> 3) * 2048u + 2u * dma_koff(_t, q); ap1[q] = (unsigned)(a1 >> 3) * 2048u + 2u * dma_koff(_t, q); }
        const int n = 4 * (_t & 31), wcq = n >> 6, s = (n >> 5) & 1, rr2 = n & 31;
        const float* bp = (s ? gptr(p.w_up_e) : gptr(p.w_gate_e)) + ((size_t)(l * 256 + e) * 1024 + 8 * (_t >> 5)) * 256 + c0 + 32 * wcq + rr2;
        __syncthreads();
        gemm_kloop_df2(acc0, acc1, smem, (const unsigned char*)x1b, ap0, ap1, bp, 256, 16, has1);
#pragma unroll
        for (int i = 0; i < 4; ++i) {
            const int rr = 64 * _wr + 16 * i + _l15;
            if (rr < nrows) {
                const int a = rl[rr].x;
#pragma unroll
                for (int j = 0; j < 2; ++j)
                    st_bf16x4(hb + (size_t)a * 256 + c0 + 32 * _wc + 16 * j + 4 * _kg, siluf_(acc0[i][j][0]) * acc0[i][j + 2][0], siluf_(acc0[i][j][1]) * acc0[i][j + 2][1], siluf_(acc0[i][j][2]) * acc0[i][j + 2][2], siluf_(acc0[i][j][3]) * acc0[i][j + 2][3]);
            }
            if (128 + rr < nrows) {
                const int a = rl[128 + rr].x;
#pragma unroll
                for (int j = 0; j < 2; ++j)
                    st_bf16x4(hb + (size_t)a * 256 + c0 + 32 * _wc + 16 * j + 4 * _kg, siluf_(acc1[i][j][0]) * acc1[i][j + 2][0], siluf_(acc1[i][j][1]) * acc1[i][j + 2][1], siluf_(acc1[i][j][2]) * acc1[i][j + 2][2], siluf_(acc1[i][j][3]) * acc1[i][j + 2][3]);
            }
        }
    }
}

static __device__ __forceinline__ void ph_expert2(CParams& p, int l, unsigned char* smem) {
    EPI_IDX;
    const int G = gridDim.x, vb = vblock();
    const int* ecnt = gptr((const int*)(p.ws + WS_CTL + CTL_ECNT)) + l * 256 * ECS;
    const ExpPre ep = expert_prefix(ecnt, smem, 4, 256);
    const int total = ep.total;
    const int2* rowl = gptr((const int2*)(p.ws + WS_ROWL));
    const bf16_t* hb = gptr((const bf16_t*)(p.ws + WS_HBUF));
    unsigned char* yb = gptr((unsigned char*)(p.ws + WS_YBUF));
    for (int u = vb; u < total; u += G) {
        int e, ustart; expert_find(ep, smem, u, e, ustart);
        const int cnt = __builtin_amdgcn_readfirstlane(ecnt[e * ECS]), npr = (cnt + 255) >> 8, r = u - ustart, nt2 = r / npr, pr = r % npr;
        const int2* rl = rowl + (size_t)e * 16384 + pr * 256;
        const int nrows = cnt - pr * 256;
        const bool has1 = nrows > 128;
        unsigned ap0[4], ap1[4];
#pragma unroll
        for (int q = 0; q < 4; ++q) { int rr = dma_row(_t, q); int r0 = rr < nrows ? rr : 0, r1 = 128 + rr < nrows ? 128 + rr : 0;
            const int a0 = rl[r0].x, a1 = rl[r1].x; ap0[q] = (unsigned)a0 * 512u + 2u * dma_koff(_t, q); ap1[q] = (unsigned)a1 * 512u + 2u * dma_koff(_t, q); }
#pragma unroll 1
        for (int h2 = 0; h2 < 2; ++h2) {
            const int n0 = (2 * nt2 + h2) * 128;
            f32x4 acc0[4][4], acc1[4][4]; zero_acc(acc0); zero_acc(acc1);
            const float* bp = gptr(p.w_down_e) + ((size_t)(l * 256 + e) * 256 + 8 * (_t >> 5)) * 1024 + n0 + 4 * (_t & 31);
            __syncthreads();
            gemm_kloop_df2(acc0, acc1, smem, (const unsigned char*)hb, ap0, ap1, bp, 1024, 4, has1);
#pragma unroll
            for (int q = 0; q < 4; ++q) { ap0[q] -= 4u * 128u; if (has1) ap1[q] -= 4u * 128u; }
#pragma unroll
            for (int i = 0; i < 4; ++i) {
                const int rr = 64 * _wr + 16 * i + _l15;
                if (rr < nrows) {
                    const int2 ent = rl[rr]; const float w = __int_as_float(ent.y);
#pragma unroll
                    for (int j = 0; j < 4; ++j) { int d = __builtin_amdgcn_cvt_pk_bf8_f32(w * acc0[i][j][0], w * acc0[i][j][1], 0, false); d = __builtin_amdgcn_cvt_pk_bf8_f32(w * acc0[i][j][2], w * acc0[i][j][3], d, true);
                        *(int*)(yb + (size_t)ent.x * 1024 + n0 + 64 * _wc + 16 * j + 4 * _kg) = d; }
                }
                if (128 + rr < nrows) {
                    const int2 ent = rl[128 + rr]; const float w = __int_as_float(ent.y);
#pragma unroll
                    for (int j = 0; j < 4; ++j) { int d = __builtin_amdgcn_cvt_pk_bf8_f32(w * acc1[i][j][0], w * acc1[i][j][1], 0, false); d = __builtin_amdgcn_cvt_pk_bf8_f32(w * acc1[i][j][2], w * acc1[i][j][3], d, true);
                        *(int*)(yb + (size_t)ent.x * 1024 + n0 + 64 * _wc + 16 * j + 4 * _kg) = d; }
                }
            }
        }
    }
}

constexpr int PH_PER_LAYER = 12;
constexpr int N_PHASES = 1 + 2 * PH_PER_LAYER;

__global__ void __launch_bounds__(NTHR, 2) fwd(Params p0) {
    extern __shared__ __attribute__((aligned(16))) unsigned char smem[];
    XcdBarrier bar = xcd_barrier_post((unsigned*)(p0.ws + WS_CTL));
    int ph = 0;
    const int ph_lo = p0.ph_lo, ph_hi = p0.ph_hi;
#ifndef REPEAT_PH
#define REPEAT_PH -1
#endif
#if REPEAT_PH >= 0
#define PHASE_REP(body) if (ph > 0 && ((ph - 1) % PH_PER_LAYER) + 1 == REPEAT_PH) { CParams* pq_ = (CParams*)__builtin_amdgcn_kernarg_segment_ptr(); asm volatile("" : "+s"(pq_)); CParams& p = *pq_; body; xcd_barrier(bar); \
    { const int l_ = (ph - 1) / PH_PER_LAYER; if (blockIdx.x == 0) { int* c_ = gptr((int*)(p.ws + WS_CTL)); if (threadIdx.x == 0) atomicExch(c_ + (CTL_ATTQ + 256 * l_) / 4, 0); \
      if (REPEAT_PH == 9) atomicExch(c_ + CTL_ECNT / 4 + (l_ * 256 + threadIdx.x) * ECS, 0); if (REPEAT_PH == 3) { atomicExch(c_ + CTL_TOT / 4 + (l_ * 512 + threadIdx.x) * TOS, 0); atomicExch(c_ + CTL_TOT / 4 + (l_ * 512 + 256 + threadIdx.x) * TOS, 0); } } } xcd_barrier(bar); }
#else
#define PHASE_REP(body)
#endif
#define PHASE(body) { if (ph >= ph_lo && ph < ph_hi) { PHASE_REP(body) CParams* pp_ = (CParams*)__builtin_amdgcn_kernarg_segment_ptr(); asm volatile("" : "+s"(pp_)); CParams& p = *pp_; body; if (ph + 1 < ph_hi) xcd_barrier(bar); } ++ph; }
    PHASE(ph_prologue(p, smem));
    for (int l = 0; l < 2; ++l) {
        PHASE(ph_inproj(p, l, smem));
        PHASE(ph_kmean_egemm(p, l, smem));
        PHASE(ph_gate_scan(p, l, smem));
        PHASE(ph_attn_ygemm(p, l, smem));
        PHASE(ph_combine_glu(p, l, smem));
        PHASE(ph_merge(p, l, smem));
        PHASE(ph_outproj(p, l, smem));
        PHASE(ph_router_shared1(p, l, smem));
        PHASE(ph_route_shared2(p, l, smem));
        PHASE(ph_expert1(p, l, smem));
        PHASE(ph_expert2(p, l, smem));
        PHASE(ph_layernorm<true>(p, gptr((const bf16_t*)(p.ws + WS_Y1)), gptr(p.ln2_g) + l * 1024, gptr(p.ln2_b) + l * 1024, (l == 1) ? gptr(p.out) : (float*)nullptr, (l == 1) ? (bf16_t*)nullptr : gptr((bf16_t*)(p.ws + WS_XB))));
    }
#undef PHASE
}

extern "C" void kernel_launch(void* const* d_in, const int* in_sizes, int n_in, void* d_out, int out_size, void* d_ws, size_t ws_size, hipStream_t stream) {
    static int grid = 0;
    if (grid == 0) {
        if (n_in != 28 || out_size != T_ * D_ || ws_size < WS_END) { fprintf(stderr, "kernel_launch: unexpected sizes n_in %d out %d ws %zu (need %zu)\n", n_in, out_size, ws_size, (size_t)WS_END); grid = -1; return; }
        int dev = 0, cus = 0, per_cu = 0;
        hipGetDevice(&dev); hipDeviceGetAttribute(&cus, hipDeviceAttributeMultiprocessorCount, dev);
        hipFuncSetAttribute((const void*)fwd, hipFuncAttributeMaxDynamicSharedMemorySize, LDS_BYTES);
        hipOccupancyMaxActiveBlocksPerMultiprocessor(&per_cu, (const void*)fwd, NTHR, LDS_BYTES);
        (void)hipGetLastError();
        if (per_cu < 1) per_cu = 1;
        grid = cus * (per_cu < 2 ? per_cu : 2);
        fprintf(stderr, "kernel_launch: cus %d per_cu %d grid %d\n", cus, per_cu, grid);
    }
    if (grid < 0) return;
    hipMemsetAsync((char*)d_ws + WS_CTL, 0, CTL_BYTES, stream);
    Params p{};
    p.x = (const float*)d_in[0]; p.positions = (const int*)d_in[1]; p.w_in = (const float*)d_in[2]; p.attn_up = (const float*)d_in[3];
    p.lam_re = (const float*)d_in[4]; p.lam_im = (const float*)d_in[5]; p.log_dt = (const float*)d_in[6]; p.b_re = (const float*)d_in[7]; p.b_im = (const float*)d_in[8];
    p.c_re = (const float*)d_in[9]; p.c_im = (const float*)d_in[10]; p.d_skip = (const float*)d_in[11]; p.w_glu = (const float*)d_in[12]; p.b_glu = (const float*)d_in[13];
    p.s5_up = (const float*)d_in[14]; p.w_o = (const float*)d_in[15]; p.ln1_g = (const float*)d_in[16]; p.ln1_b = (const float*)d_in[17];
    p.w_router = (const float*)d_in[18]; p.router_bias = (const float*)d_in[19]; p.w_gate_e = (const float*)d_in[20]; p.w_up_e = (const float*)d_in[21]; p.w_down_e = (const float*)d_in[22];
    p.ws_gate = (const float*)d_in[23]; p.ws_up = (const float*)d_in[24]; p.ws_down = (const float*)d_in[25]; p.ln2_g = (const float*)d_in[26]; p.ln2_b = (const float*)d_in[27];
    p.out = (float*)d_out; p.ws = (unsigned char*)d_ws;
#if N_LAUNCH_MODE == 1
    p.ph_lo = 0; p.ph_hi = N_PHASES;
    hipLaunchKernelGGL(fwd, dim3(grid), dim3(NTHR), LDS_BYTES, stream, p);
#else
    for (int ph = 0; ph < N_PHASES; ++ph) { p.ph_lo = ph; p.ph_hi = ph + 1; hipLaunchKernelGGL(fwd, dim3(grid), dim3(NTHR), LDS_BYTES, stream, p); }
#endif
}
```

```cpp
#include <hip/hip_runtime.h>
#include <stdint.h>
#include <stdio.h>

#ifndef N_LAUNCH_MODE
#define N_LAUNCH_MODE 1
#endif

typedef unsigned short bf16_t;
typedef short bf16x8 __attribute__((ext_vector_type(8)));
typedef short bf16x4 __attribute__((ext_vector_type(4)));
typedef float f32x4 __attribute__((ext_vector_type(4)));
typedef float f32x16 __attribute__((ext_vector_type(16)));
typedef unsigned u32x4 __attribute__((ext_vector_type(4)));
typedef unsigned u32x2 __attribute__((ext_vector_type(2)));
typedef float f32x2v __attribute__((ext_vector_type(2)));

constexpr int T_ = 16384, D_ = 1024, S_ = 8192, NBLK = 32, NH = 8, HD = 64;
constexpr int INC = 4096;
constexpr int NE = 256, TOPK = 8, EH = 256;
constexpr float DN_ALPHA = 1.4142135623730951f;
constexpr float LN_EPS = 1e-5f;
constexpr float NEG_INF = -1e30f;
constexpr int NTHR = 256;
constexpr int LDS_BYTES = 80 * 1024;

constexpr size_t MB = 1024ull * 1024ull;
constexpr size_t WS_CTL = 0;
constexpr size_t CTL_BYTES = 262144;
constexpr int ECS = 64, TOS = 16;
constexpr size_t CTL_ECNT = 16384;
constexpr size_t CTL_ATTQ = CTL_ECNT + 2 * 256 * ECS * 4;
constexpr size_t CTL_TOT = CTL_ATTQ + 1024;
constexpr size_t CTL_RBASE = CTL_TOT + 2 * 512 * TOS * 4;
static_assert(CTL_RBASE + 2 * 256 * 4 <= CTL_BYTES, "control block overflow");
constexpr size_t WS_CS = WS_CTL + CTL_BYTES;
constexpr size_t WS_XB = WS_CS + 4 * MB;
constexpr size_t WS_XF = WS_XB + 32 * MB;
constexpr size_t WS_XQ = WS_XF, WS_WIQ = WS_XF + 16 * MB, WS_X1Q = WS_XF + 24 * MB  ;
constexpr size_t WS_WSQ = WS_XF + 40 * MB;
constexpr size_t WS_WOQ = WS_XF + 41 * MB;
constexpr size_t WS_WAQ = WS_XF + 43 * MB, WS_WSUQ = WS_XF + 44 * MB;
constexpr size_t WS_WSDQ = WS_XF + 45 * MB;
constexpr float WIQ_SCALE = 64.f;
constexpr size_t WS_Q = WS_XF + 64 * MB;
constexpr size_t WS_K = WS_Q + 16 * MB;
constexpr size_t WS_VT = WS_K + 16 * MB;
constexpr size_t WS_UG = WS_VT + 16 * MB;
constexpr size_t WS_GA = WS_UG + 16 * MB;
constexpr size_t WS_GS = WS_GA + 32 * MB;
constexpr size_t WS_KMEAN = WS_GS + 32 * MB;
constexpr size_t WS_CNT = WS_KMEAN + 1 * MB;
constexpr size_t WS_LIST = WS_CNT + 1 * MB;
constexpr size_t WS_LSE = WS_LIST + 8 * MB;
constexpr size_t WS_PO = WS_LSE + 2 * MB;
constexpr size_t WS_AO = WS_PO + 64 * MB;
constexpr size_t WS_TM = WS_AO + 16 * MB;
constexpr size_t WS_WE = WS_TM + 32 * MB;
constexpr size_t WS_WC = WS_WE + 8 * MB;
constexpr size_t WS_AL = WS_WC + 8 * MB;
constexpr size_t WS_E = WS_AL + 1 * MB;
constexpr size_t WS_HIN = WS_E + 8 * MB;
constexpr size_t WS_Z = WS_HIN + 4 * MB;
constexpr size_t WS_SGL = WS_Z + 16 * MB;
constexpr size_t WS_MIX = WS_SGL + 16 * MB;
constexpr size_t WS_Y1 = WS_MIX + 32 * MB;
constexpr size_t WS_X1F = WS_Y1 + 64 * MB;
constexpr size_t WS_X1B = WS_X1F + 64 * MB;
constexpr size_t WS_SC = WS_X1B + 32 * MB;
constexpr size_t WS_HS = WS_SC + 16 * MB;
constexpr size_t WS_ROWL = WS_HS + 8 * MB;
constexpr size_t WS_HBUF = WS_ROWL + 32 * MB;
constexpr size_t WS_YBUF = WS_HBUF + 64 * MB;
constexpr size_t WS_WI = WS_YBUF + 256 * MB;
constexpr size_t WS_WA = WS_WI + 16 * MB;
constexpr size_t WS_WSU = WS_WA + 2 * MB;
constexpr size_t WS_WG = WS_WSU + 2 * MB;
constexpr size_t WS_WO = WS_WG + 1 * MB;
constexpr size_t WS_WRS = WS_WO + 4 * MB;
constexpr size_t WS_WSD = WS_WRS + 3 * MB;
constexpr size_t WS_KM = WS_WSD + 1 * MB;
constexpr size_t WS_END = WS_KM + 2 * MB;

struct Params {
    const float* x; const int* positions; const float* w_in; const float* attn_up;
    const float* lam_re; const float* lam_im; const float* log_dt; const float* b_re; const float* b_im;
    const float* c_re; const float* c_im; const float* d_skip; const float* w_glu; const float* b_glu;
    const float* s5_up; const float* w_o; const float* ln1_g; const float* ln1_b;
    const float* w_router; const float* router_bias; const float* w_gate_e; const float* w_up_e; const float* w_down_e;
    const float* ws_gate; const float* ws_up; const float* ws_down; const float* ln2_g; const float* ln2_b;
    float* out; unsigned char* ws;
    int ph_lo, ph_hi;
};

typedef const __attribute__((address_space(4))) Params CParams;

#define XB_TMO      128
#define XB_XCNT(j)  (256  + 64 * (j))
#define XB_XSUB(j)  (1280 + 64 * (j))
#define XB_XGEN(j)  (2304 + 64 * (j))
#define XB_TOP      3328
#define XB_TOPGEN   3392
#define XCD_BAR_WORDS 3456
#define XB_SPIN_CAP (1u << 22)
#define LAS __attribute__((address_space(3)))

__device__ __forceinline__ unsigned xb_ld(unsigned* p)              { return __hip_atomic_load(p, __ATOMIC_RELAXED, __HIP_MEMORY_SCOPE_AGENT); }
__device__ __forceinline__ unsigned xb_add(unsigned* p, unsigned v) { return __hip_atomic_fetch_add(p, v, __ATOMIC_RELAXED, __HIP_MEMORY_SCOPE_AGENT); }
__device__ __forceinline__ unsigned xb_xcc_id() { return (unsigned)__builtin_amdgcn_s_getreg((3 << 11) | 20) & 0xFu; }
#define XB_SPIN(cond, bar) do { unsigned _sp = 0; while (cond) { __builtin_amdgcn_s_sleep(1); \
    if ((++_sp & 255u) == 0u) { if (xb_ld(&(bar)[XB_TMO])) break; if (_sp > XB_SPIN_CAP) { atomicAdd(&(bar)[XB_TMO], 1u); break; } } } } while (0)

struct XcdBarrier { unsigned* bar; unsigned x; unsigned nloc, nx; };

__device__ __forceinline__ XcdBarrier xcd_barrier_post(unsigned* bar) {
    XcdBarrier b; b.bar = bar; b.x = xb_xcc_id(); b.nloc = 0u; b.nx = 0u;
    if (threadIdx.x == 0) (void)xb_add(&bar[XB_XCNT(b.x)], 1u);
    return b;
}
__device__ __forceinline__ void xcd_barrier_complete(unsigned* bar, unsigned x, unsigned& nloc, unsigned& nx) {
    const unsigned G = gridDim.x * gridDim.y * gridDim.z;
    unsigned sum, cnt, mine, sp = 0u;
    for (;;) {
        sum = 0u; cnt = 0u; mine = 0u;
#pragma unroll
        for (unsigned j = 0; j < 16; ++j) { const unsigned c = xb_ld(&bar[XB_XCNT(j)]); sum += c; cnt += (c > 0u) ? 1u : 0u; mine = (j == x) ? c : mine; }
        if (sum == G) break;
        __builtin_amdgcn_s_sleep(1);
        if ((++sp & 255u) == 0u) { if (xb_ld(&bar[XB_TMO])) break; if (sp > XB_SPIN_CAP) { atomicAdd(&bar[XB_TMO], 1u); break; } }
    }
    nloc = mine > 0u ? mine : 1u; nx = cnt > 0u ? cnt : 1u;
}
__device__ __forceinline__ void xcd_barrier(XcdBarrier& b) {
    asm volatile("s_waitcnt vmcnt(0)" ::: "memory");
    __syncthreads();
    if (threadIdx.x == 0) {
        unsigned* bar = b.bar;
        __builtin_amdgcn_s_waitcnt(0);
        unsigned nloc = b.nloc, nx = b.nx;
        if (nloc == 0u) { xcd_barrier_complete(bar, b.x, nloc, nx); b.nloc = nloc; b.nx = nx; }
        const unsigned old = xb_add(&bar[XB_XSUB(b.x)], 1u);
        const unsigned gen = old / nloc;
        if (old + 1u == (gen + 1u) * nloc) {
            __builtin_amdgcn_fence(__ATOMIC_RELEASE, "agent");
            asm volatile("s_waitcnt vmcnt(0)" ::: "memory");
            const unsigned og = xb_add(&bar[XB_TOP], 1u);
            const unsigned tg = og / nx;
            if (og + 1u == (tg + 1u) * nx) xb_add(&bar[XB_TOPGEN], 1u);
            else XB_SPIN(xb_ld(&bar[XB_TOPGEN]) == tg, bar);
            __builtin_amdgcn_fence(__ATOMIC_ACQUIRE, "agent");
            xb_add(&bar[XB_XGEN(b.x)], 1u);
            asm volatile("s_waitcnt vmcnt(0)" ::: "memory");
        } else {
            XB_SPIN(xb_ld(&bar[XB_XGEN(b.x)]) == gen, bar);
            __builtin_amdgcn_fence(__ATOMIC_ACQUIRE, "agent");
            asm volatile("s_waitcnt vmcnt(0)" ::: "memory");
        }
    }
    __syncthreads();
}

__device__ __forceinline__ unsigned cvt_pk_bf16(float lo, float hi) { unsigned r; asm volatile("v_cvt_pk_bf16_f32 %0, %1, %2" : "=v"(r) : "v"(lo), "v"(hi)); return r; }
__device__ __forceinline__ bf16_t f2bf(float f) { return (bf16_t)(cvt_pk_bf16(f, 0.f) & 0xffffu); }
__device__ __forceinline__ float bf2f(unsigned v) { return __uint_as_float(v << 16); }
__device__ __forceinline__ float bflo(unsigned w) { return __uint_as_float(w << 16); }
__device__ __forceinline__ float bfhi(unsigned w) { return __uint_as_float(w & 0xffff0000u); }
__device__ __forceinline__ float sigmoidf_(float v) { return __builtin_amdgcn_rcpf(1.f + __expf(-v)); }
__device__ __forceinline__ float siluf_(float v) { return v * __builtin_amdgcn_rcpf(1.f + __expf(-v)); }
__device__ __forceinline__ float gelu_tanh(float v) {
    const float u = 0.7978845608028654f * (v + 0.044715f * v * v * v);
    const float e = __expf(2.f * u);
    const float th = 1.f - 2.f * __builtin_amdgcn_rcpf(1.f + e);
    return 0.5f * v * (1.f + th);
}
template <class T> __device__ __forceinline__ T* gptr(T* q) { return (T*)(__attribute__((address_space(1))) T*)q; }
__device__ __forceinline__ int otid() { int t = threadIdx.x; asm volatile("" : "+v"(t)); return t; }
__device__ __forceinline__ int obid() { int b = blockIdx.x; asm volatile("" : "+s"(b)); return b; }
__device__ __forceinline__ int vblock() {
    const int G = gridDim.x, b = obid();
    if ((G & 7) == 0) return (b & 7) * (G >> 3) + (b >> 3);
    return b;
}

constexpr int GA_BYTES = 128 * 64 * 2;

#define AS1 __attribute__((address_space(1)))
__device__ __forceinline__ void dma16(const void* g, unsigned char* lds_wave_base) {
    __builtin_amdgcn_global_load_lds((const AS1 unsigned*)g, (LAS unsigned*)lds_wave_base, 16, 0, 0);
}
__device__ __forceinline__ int dma_row(int t, int q) { return 32 * (t >> 6) + 8 * q + ((t & 63) >> 3); }
__device__ __forceinline__ int dma_koff(int t, int q) { return 8 * ((t & 7) ^ ((4 * q + ((t & 63) >> 4)) & 7)); }

__device__ __forceinline__ void gemm_step(f32x4 (&acc)[4][4], const unsigned char* A, const unsigned char* B, int ra0, int ra1, int rb0, int rb1) {
#pragma unroll
    for (int s = 0; s < 2; ++s) {
        bf16x8 af[4], bf[4];
#pragma unroll
        for (int i = 0; i < 4; ++i) af[i] = *(const bf16x8*)(A + (s ? ra1 : ra0) + i * 2048);
#pragma unroll
        for (int j = 0; j < 4; ++j) bf[j] = *(const bf16x8*)(B + (s ? rb1 : rb0) + j * 2048);
        __builtin_amdgcn_s_setprio(1);
#pragma unroll
        for (int i = 0; i < 4; ++i)
#pragma unroll
            for (int j = 0; j < 4; ++j) acc[i][j] = __builtin_amdgcn_mfma_f32_16x16x32_bf16(bf[j], af[i], acc[i][j], 0, 0, 0);
        __builtin_amdgcn_s_setprio(0);
    }
}

typedef int i32x4 __attribute__((ext_vector_type(4)));
typedef int i32x8 __attribute__((ext_vector_type(8)));
__device__ __forceinline__ void gemm_step_fp8(f32x4 (&acc)[4][4], const unsigned char* A, const unsigned char* B, int ra0, int ra1, int rb0, int rb1) {
    i32x8 af[4], bf[4];
#pragma unroll
    for (int i = 0; i < 4; ++i) { const i32x4 lo = *(const i32x4*)(A + ra0 + i * 2048), hi = *(const i32x4*)(A + ra1 + i * 2048); af[i] = (i32x8){lo[0], lo[1], lo[2], lo[3], hi[0], hi[1], hi[2], hi[3]}; }
#pragma unroll
    for (int j = 0; j < 4; ++j) { const i32x4 lo = *(const i32x4*)(B + rb0 + j * 2048), hi = *(const i32x4*)(B + rb1 + j * 2048); bf[j] = (i32x8){lo[0], lo[1], lo[2], lo[3], hi[0], hi[1], hi[2], hi[3]}; }
    __builtin_amdgcn_s_setprio(1);
#pragma unroll
    for (int i = 0; i < 4; ++i)
#pragma unroll
        for (int j = 0; j < 4; ++j) acc[i][j] = __builtin_amdgcn_mfma_scale_f32_16x16x128_f8f6f4(bf[j], af[i], acc[i][j], 0, 0, 0, 0, 0, 0);
    __builtin_amdgcn_s_setprio(0);
}

template <bool FP8 = false, bool PRE = false>
__device__ __forceinline__ void gemm_kloop_dd(f32x4 (&acc)[4][4], unsigned char* smem, const bf16_t* (&ap)[4], const bf16_t* (&bq)[4], int nk) {
    const int t = otid(), lane = t & 63, wid = __builtin_amdgcn_readfirstlane(t >> 6), wr = wid >> 1, wc = wid & 1, l15 = lane & 15, kg = lane >> 4;
    const int sw = (l15 >> 1) & 7;
    const int ra0 = (wr * 64 + l15) * 128 + (((0 + kg) ^ sw) << 4), ra1 = (wr * 64 + l15) * 128 + (((4 + kg) ^ sw) << 4);
    const int rb0 = (wc * 64 + l15) * 128 + (((0 + kg) ^ sw) << 4), rb1 = (wc * 64 + l15) * 128 + (((4 + kg) ^ sw) << 4);
    unsigned char* wbase = smem + wid * 4096;
    auto issue = [&](int stage) {
#pragma unroll
        for (int q = 0; q < 4; ++q) { dma16(ap[q], wbase + stage * 32768 + q * 1024); ap[q] += 64; }
#pragma unroll
        for (int q = 0; q < 4; ++q) { dma16(bq[q], wbase + stage * 32768 + 16384 + q * 1024); bq[q] += 64; }
    };
    if (!PRE) issue(0);
    asm volatile("s_waitcnt vmcnt(0)" ::: "memory");
    __syncthreads();
    for (int kt = 0; kt < nk; ++kt) {
        if (kt + 1 < nk) issue((kt + 1) & 1);
        const unsigned char* A = smem + (kt & 1) * 32768;
        if (FP8) gemm_step_fp8(acc, A, A + 16384, ra0, ra1, rb0, rb1); else gemm_step(acc, A, A + 16384, ra0, ra1, rb0, rb1);
        asm volatile("s_waitcnt vmcnt(0)" ::: "memory");
        __syncthreads();
    }
}

__device__ __forceinline__ void gemm_kloop_df(f32x4 (&acc)[4][4], unsigned char* smem, const bf16_t* (&ap)[4], const float* bp, size_t ldb, int nk) {
    const int t = otid(), lane = t & 63, wid = __builtin_amdgcn_readfirstlane(t >> 6), wr = wid >> 1, wc = wid & 1, l15 = lane & 15, kg = lane >> 4;
    const int sw = (l15 >> 1) & 7;
    const int ra0 = (wr * 64 + l15) * 128 + (((0 + kg) ^ sw) << 4), ra1 = (wr * 64 + l15) * 128 + (((4 + kg) ^ sw) << 4);
    const int rb0 = (wc * 64 + l15) * 128 + (((0 + kg) ^ sw) << 4), rb1 = (wc * 64 + l15) * 128 + (((4 + kg) ^ sw) << 4);
    const int bqd = t & 31, bc = t >> 5;
    unsigned char* wbase = smem + wid * 4096;
    unsigned char* Bst = smem + 49152;
    f32x4 rB0[8], rB1[8];
    int sa_i = 0, sa_r = 0;
#define DF_ISSUE_A() do { _Pragma("unroll") for (int q = 0; q < 4; ++q) { dma16(ap[q], wbase + sa_i * 16384 + q * 1024); ap[q] += 64; } asm volatile("" ::: "memory"); sa_i = (sa_i == 2) ? 0 : sa_i + 1; } while (0)
#define DF_LOAD_B(R) do { _Pragma("unroll") for (int j = 0; j < 8; ++j) R[j] = *(const f32x4*)(bp + (size_t)j * ldb); bp += 64 * ldb; asm volatile("" ::: "memory"); } while (0)
#define DF_STORE_B(R, stage) do { unsigned char* B_ = Bst + (stage) * 16384; _Pragma("unroll") for (int ii = 0; ii < 4; ++ii) { u32x4 v_; \
        v_[0] = cvt_pk_bf16(R[0][ii], R[1][ii]); v_[1] = cvt_pk_bf16(R[2][ii], R[3][ii]); v_[2] = cvt_pk_bf16(R[4][ii], R[5][ii]); v_[3] = cvt_pk_bf16(R[6][ii], R[7][ii]); \
        const int row_ = 4 * bqd + ii; *(u32x4*)(B_ + row_ * 128 + ((bc ^ ((row_ >> 1) & 7)) << 4)) = v_; } } while (0)
#define DF_SYNC(keep) do { if (keep) asm volatile("s_waitcnt vmcnt(12)" ::: "memory"); else asm volatile("s_waitcnt vmcnt(0)" ::: "memory"); asm volatile("s_waitcnt lgkmcnt(0)" ::: "memory"); __builtin_amdgcn_s_barrier(); asm volatile("" ::: "memory"); } while (0)
#define DF_COMPUTE(bstage) do { gemm_step(acc, smem + sa_r * 16384, Bst + (bstage) * 16384, ra0, ra1, rb0, rb1); sa_r = (sa_r == 2) ? 0 : sa_r + 1; } while (0)
    DF_ISSUE_A(); DF_LOAD_B(rB0);
    if (nk > 1) { DF_ISSUE_A(); DF_LOAD_B(rB1); }
    DF_STORE_B(rB0, 0);
    DF_SYNC(nk > 1);
    for (int kt = 0; kt < nk; kt += 2) {
        if (kt + 2 < nk) { DF_ISSUE_A(); DF_LOAD_B(rB0); }
        DF_COMPUTE(0);
        if (kt + 1 < nk) DF_STORE_B(rB1, 1);
        DF_SYNC(kt + 2 < nk);
        if (kt + 1 >= nk) break;
        if (kt + 3 < nk) { DF_ISSUE_A(); DF_LOAD_B(rB1); }
        DF_COMPUTE(1);
        if (kt + 2 < nk) DF_STORE_B(rB0, 0);
        DF_SYNC(kt + 3 < nk);
    }
#undef DF_ISSUE_A
#undef DF_LOAD_B
#undef DF_STORE_B
#undef DF_SYNC
#undef DF_COMPUTE
}

__device__ __forceinline__ void gemm_step_lr(f32x4 (&acc)[4][4], const unsigned char* A, const unsigned char* B, int ra0, int ra1, int rb0, int rb1) {
#pragma unroll
    for (int s = 0; s < 2; ++s) {
        bf16x8 af[4];
#pragma unroll
        for (int i = 0; i < 4; ++i) af[i] = *(const bf16x8*)(A + (s ? ra1 : ra0) + i * 2048);
#pragma unroll
        for (int j = 0; j < 4; ++j) {
            const bf16x8 bf = *(const bf16x8*)(B + (s ? rb1 : rb0) + j * 2048);
#pragma unroll
            for (int i = 0; i < 4; ++i) acc[i][j] = __builtin_amdgcn_mfma_f32_16x16x32_bf16(bf, af[i], acc[i][j], 0, 0, 0);
            __builtin_amdgcn_sched_barrier(0);
        }
    }
}
__device__ __forceinline__ void gemm_kloop_df2(f32x4 (&acc0)[4][4], f32x4 (&acc1)[4][4], unsigned char* smem, const unsigned char* abase, unsigned (&ap0)[4], unsigned (&ap1)[4], const float* bp, size_t ldb, int nk, bool has1) {
    const int t = otid(), lane = t & 63, wid = __builtin_amdgcn_readfirstlane(t >> 6), wr = wid >> 1, wc = wid & 1, l15 = lane & 15, kg = lane >> 4;
    const int sw = (l15 >> 1) & 7;
    const int ra0 = (wr * 64 + l15) * 128 + (((0 + kg) ^ sw) << 4), ra1 = (wr * 64 + l15) * 128 + (((4 + kg) ^ sw) << 4);
    const int rb0 = (wc * 64 + l15) * 128 + (((0 + kg) ^ sw) << 4), rb1 = (wc * 64 + l15) * 128 + (((4 + kg) ^ sw) << 4);
    const int bqd = t & 31, bc = t >> 5;
    unsigned char* wbase = smem + wid * 4096;
    unsigned char* Bst = smem + 49152;
    f32x4 rB[4];
    int sa_i = 0, sa_r = 0;
#define D2_ISSUE(AP) do { _Pragma("unroll") for (int q = 0; q < 4; ++q) { dma16(abase + AP[q], wbase + sa_i * 16384 + q * 1024); AP[q] += 128u; } asm volatile("" ::: "memory"); sa_i = (sa_i == 2) ? 0 : sa_i + 1; } while (0)
#define D2_LOAD_BH(h) do { _Pragma("unroll") for (int j = 0; j < 4; ++j) rB[j] = *(const f32x4*)(bp + (size_t)(4 * (h) + j) * ldb); asm volatile("" ::: "memory"); } while (0)
#define D2_STORE_BH(stage, h) do { unsigned char* B_ = Bst + (stage) * 16384; _Pragma("unroll") for (int ii = 0; ii < 4; ++ii) { u32x2 v_; \
        v_[0] = cvt_pk_bf16(rB[0][ii], rB[1][ii]); v_[1] = cvt_pk_bf16(rB[2][ii], rB[3][ii]); \
        const int row_ = 4 * bqd + ii; *(u32x2*)(B_ + row_ * 128 + ((bc ^ ((row_ >> 1) & 7)) << 4) + 8 * (h)) = v_; } } while (0)
#define D2_BAR(inflight) do { if (inflight) asm volatile("s_waitcnt vmcnt(4)" ::: "memory"); else asm volatile("s_waitcnt vmcnt(0)" ::: "memory"); asm volatile("s_waitcnt lgkmcnt(0)" ::: "memory"); __builtin_amdgcn_s_barrier(); asm volatile("" ::: "memory"); } while (0)
#define D2_COMPUTE(ACC, bstage) do { gemm_step_lr(ACC, smem + sa_r * 16384, Bst + (bstage) * 16384, ra0, ra1, rb0, rb1); sa_r = (sa_r == 2) ? 0 : sa_r + 1; } while (0)
    {
        f32x4 rP[4];
        D2_LOAD_BH(0);
#pragma unroll
        for (int j = 0; j < 4; ++j) rP[j] = *(const f32x4*)(bp + (size_t)(4 + j) * ldb);
        asm volatile("" ::: "memory");
        D2_STORE_BH(0, 0);
#pragma unroll
        for (int j = 0; j < 4; ++j) rB[j] = rP[j];
        D2_STORE_BH(0, 1);
    }
    bp += 64 * ldb;
    D2_ISSUE(ap0);
    if (has1) D2_ISSUE(ap1);
    D2_BAR(false);
    for (int k = 0; k < nk; ++k) {
        const bool more = (k + 1 < nk);
        const int bs = k & 1;
        if (more) { D2_LOAD_BH(0); D2_ISSUE(ap0); }
        D2_COMPUTE(acc0, bs);
        if (more) D2_STORE_BH(bs ^ 1, 0);
        D2_BAR(more);
        if (more) D2_LOAD_BH(1);
        if (has1) {
            if (more) D2_ISSUE(ap1);
            D2_COMPUTE(acc1, bs);
        }
        if (more) { D2_STORE_BH(bs ^ 1, 1); bp += 64 * ldb; }
        D2_BAR(more && has1);
    }
#undef D2_ISSUE
#undef D2_LOAD_BH
#undef D2_STORE_BH
#undef D2_BAR
#undef D2_COMPUTE
}

__device__ __forceinline__ void gemm_dd(f32x4 (&acc)[4][4], unsigned char* smem, const bf16_t* A, size_t lda, int m0, const bf16_t* Bt, size_t ldbt, int n0, int nk) {
    const int t = otid();
    const bf16_t* ap[4]; const bf16_t* bq[4];
#pragma unroll
    for (int q = 0; q < 4; ++q) { ap[q] = A + (size_t)(m0 + dma_row(t, q)) * lda + dma_koff(t, q); bq[q] = Bt + (size_t)(n0 + dma_row(t, q)) * ldbt + dma_koff(t, q); }
    gemm_kloop_dd<false>(acc, smem, ap, bq, nk);
}
__device__ __forceinline__ void gemm_dq(f32x4 (&acc)[4][4], unsigned char* smem, const unsigned char* A, size_t lda, int m0, const unsigned char* Bt, size_t ldbt, int n0, int nk) {
    const int t = otid();
    const bf16_t* ap[4]; const bf16_t* bq[4];
#pragma unroll
    for (int q = 0; q < 4; ++q) { ap[q] = (const bf16_t*)(A + (size_t)(m0 + dma_row(t, q)) * lda) + dma_koff(t, q); bq[q] = (const bf16_t*)(Bt + (size_t)(n0 + dma_row(t, q)) * ldbt) + dma_koff(t, q); }
    gemm_kloop_dd<true>(acc, smem, ap, bq, nk);
}
__device__ __forceinline__ void gemm_dq_prefetch(const bf16_t* (&ap)[4], const bf16_t* (&bq)[4], unsigned char* smem, const unsigned char* A, size_t lda, int m0, const unsigned char* Bt, size_t ldbt, int n0) {
    const int t = otid(), wid = __builtin_amdgcn_readfirstlane(t >> 6);
    unsigned char* wbase = smem + wid * 4096;
#pragma unroll
    for (int q = 0; q < 4; ++q) { ap[q] = (const bf16_t*)(A + (size_t)(m0 + dma_row(t, q)) * lda) + dma_koff(t, q); bq[q] = (const bf16_t*)(Bt + (size_t)(n0 + dma_row(t, q)) * ldbt) + dma_koff(t, q); }
#pragma unroll
    for (int q = 0; q < 4; ++q) { dma16(ap[q], wbase + q * 1024); ap[q] += 64; }
#pragma unroll
    for (int q = 0; q < 4; ++q) { dma16(bq[q], wbase + 16384 + q * 1024); bq[q] += 64; }
    asm volatile("" ::: "memory");
}

template <bool FP8 = false>
__device__ __forceinline__ void gemm_dd_seq(f32x4 (&acc1)[4][4], f32x4 (&acc2)[4][4], unsigned char* smem, const bf16_t* A1, size_t lda1, const bf16_t* B1, size_t ldb1, int nk1,
                                            const bf16_t* A2, size_t lda2, const bf16_t* B2, size_t ldb2, int nk2, int m0, int n0) {
    const int t = otid(), lane = t & 63, wid = __builtin_amdgcn_readfirstlane(t >> 6), wr = wid >> 1, wc = wid & 1, l15 = lane & 15, kg = lane >> 4;
    const int sw = (l15 >> 1) & 7;
    const int ra0 = (wr * 64 + l15) * 128 + (((0 + kg) ^ sw) << 4), ra1 = (wr * 64 + l15) * 128 + (((4 + kg) ^ sw) << 4);
    const int rb0 = (wc * 64 + l15) * 128 + (((0 + kg) ^ sw) << 4), rb1 = (wc * 64 + l15) * 128 + (((4 + kg) ^ sw) << 4);
    unsigned char* wbase = smem + wid * 4096;
    const bf16_t* ap[4]; const bf16_t* bq[4];
#pragma unroll
    for (int q = 0; q < 4; ++q) { ap[q] = A1 + (size_t)(m0 + dma_row(t, q)) * lda1 + dma_koff(t, q); bq[q] = B1 + (size_t)(n0 + dma_row(t, q)) * ldb1 + dma_koff(t, q); }
    auto issue = [&](int stage) {
#pragma unroll
        for (int q = 0; q < 4; ++q) { dma16(ap[q], wbase + stage * 32768 + q * 1024); ap[q] += 64; }
#pragma unroll
        for (int q = 0; q < 4; ++q) { dma16(bq[q], wbase + stage * 32768 + 16384 + q * 1024); bq[q] += 64; }
    };
    issue(0);
    asm volatile("s_waitcnt vmcnt(0)" ::: "memory");
    __syncthreads();
    for (int kt = 0; kt + 1 < nk1; ++kt) {
        issue((kt + 1) & 1);
        const unsigned char* A = smem + (kt & 1) * 32768;
        if (FP8) gemm_step_fp8(acc1, A, A + 16384, ra0, ra1, rb0, rb1); else gemm_step(acc1, A, A + 16384, ra0, ra1, rb0, rb1);
        asm volatile("s_waitcnt vmcnt(0)" ::: "memory");
        __syncthreads();
    }
    {
#pragma unroll
        for (int q = 0; q < 4; ++q) { ap[q] = A2 + (size_t)(m0 + dma_row(t, q)) * lda2 + dma_koff(t, q); bq[q] = B2 + (size_t)(n0 + dma_row(t, q)) * ldb2 + dma_koff(t, q); }
        issue(nk1 & 1);
        const unsigned char* A = smem + ((nk1 - 1) & 1) * 32768;
        if (FP8) gemm_step_fp8(acc1, A, A + 16384, ra0, ra1, rb0, rb1); else gemm_step(acc1, A, A + 16384, ra0, ra1, rb0, rb1);
        asm volatile("s_waitcnt vmcnt(0)" ::: "memory");
        __syncthreads();
    }
    for (int kt = 0; kt < nk2; ++kt) {
        if (kt + 1 < nk2) issue((nk1 + kt + 1) & 1);
        const unsigned char* A = smem + ((nk1 + kt) & 1) * 32768;
        if (FP8) gemm_step_fp8(acc2, A, A + 16384, ra0, ra1, rb0, rb1); else gemm_step(acc2, A, A + 16384, ra0, ra1, rb0, rb1);
        asm volatile("s_waitcnt vmcnt(0)" ::: "memory");
        __syncthreads();
    }
}

struct TileSched {
    int x, rank, R, nN, SN, SM, n_sn, U;
    __device__ __forceinline__ void init(int vb, int G, int nN_) { R = G >> 3; x = vb / R; rank = vb % R; nN = nN_; SN = nN < 8 ? nN : 8; SM = nN <= 4 ? 16 : 8; n_sn = nN / SN; U = 16 * nN; }
    __device__ __forceinline__ void get(int i, int& mt, int& nt) const { const int P = SM * SN, st = i / P, w = i % P, mg = st / n_sn, ng = st % n_sn; mt = 16 * x + SM * mg + (w % SM); nt = SN * ng + (w / SM); }
};

__device__ __forceinline__ void zero_acc(f32x4 (&acc)[4][4]) {
#pragma unroll
    for (int i = 0; i < 4; ++i)
#pragma unroll
        for (int j = 0; j < 4; ++j) acc[i][j] = (f32x4){0.f, 0.f, 0.f, 0.f};
}

#define EPI_IDX const int _t = otid(), _lane = _t & 63, _wid = _t >> 6, _wr = _wid >> 1, _wc = _wid & 1, _l15 = _lane & 15, _kg = _lane >> 4

__device__ __forceinline__ void st_bf16x4(bf16_t* p, float a, float b, float c, float d) { u32x2 v; v[0] = cvt_pk_bf16(a, b); v[1] = cvt_pk_bf16(c, d); *(u32x2*)p = v; }

static __device__ __forceinline__ void ph_prologue(CParams& p, unsigned char* smem) {
    const int G = gridDim.x, b = obid(), t = otid();
    {
        float2* cs = gptr((float2*)(p.ws + WS_CS));
        for (int idx = b * NTHR + t; idx < T_ * 32; idx += G * NTHR) {
            const int tok = idx >> 5, f = idx & 31;
            const float inv = powf(10000.f, -(float)(2 * f) / 64.f);
            const float ang = (float)gptr(p.positions)[tok] * inv;
            float s, c; sincosf(ang, &s, &c);
            cs[idx] = make_float2(c, s);
        }
    }
    {
        bf16_t* xb = gptr((bf16_t*)(p.ws + WS_XB)); unsigned char* xq = gptr((unsigned char*)(p.ws + WS_XQ));
        const size_t nq = (size_t)T_ * D_ / 4, step = (size_t)G * NTHR;
        size_t idx = (size_t)b * NTHR + t;
        for (; idx + 7 * step < nq; idx += 8 * step) {
            f32x4 v[8];
#pragma unroll
            for (int k = 0; k < 8; ++k) v[k] = *(const f32x4*)(gptr(p.x) + (idx + k * step) * 4);
#pragma unroll
            for (int k = 0; k < 8; ++k) { st_bf16x4(xb + (idx + k * step) * 4, v[k][0], v[k][1], v[k][2], v[k][3]);
                int d = __builtin_amdgcn_cvt_pk_fp8_f32(v[k][0], v[k][1], 0, false); d = __builtin_amdgcn_cvt_pk_fp8_f32(v[k][2], v[k][3], d, true); ((int*)xq)[idx + k * step] = d; }
        }
        for (; idx < nq; idx += step) {
            const f32x4 v = *(const f32x4*)(gptr(p.x) + idx * 4);
            st_bf16x4(xb + idx * 4, v[0], v[1], v[2], v[3]);
            int d = __builtin_amdgcn_cvt_pk_fp8_f32(v[0], v[1], 0, false); d = __builtin_amdgcn_cvt_pk_fp8_f32(v[2], v[3], d, true); ((int*)xq)[idx] = d;
        }
    }
    {
        for (int u = b; u < 2 * 928; u += G) {
            const int l = u / 928; int r = u % 928;
            const float* src; bf16_t* dst; int K, N, kt, ntl;
            const int nq = t & 31, kk = t >> 5;
            const float* sp; int drow;
            bool wiq = false; unsigned char* dq = nullptr; int dqrow = 0;
            if (r < 512) { K = 1024; N = 4096; kt = r >> 5; ntl = r & 31; wiq = true; src = gptr(p.w_in) + (size_t)l * 1024 * 4096; dst = gptr((bf16_t*)(p.ws + WS_WI)) + (size_t)l * 4096 * 1024; drow = ntl * 128 + 4 * nq; sp = src + drow;
                dq = gptr((unsigned char*)(p.ws + WS_WIQ)) + (size_t)l * 4096 * 1024; dqrow = drow; }
            else if (r < 576) { r -= 512; K = 512; N = 1024; kt = r >> 3; ntl = r & 7; src = gptr(p.attn_up) + (size_t)l * 512 * 1024; dst = gptr((bf16_t*)(p.ws + WS_WA)) + (size_t)l * 1024 * 512; drow = ntl * 128 + 4 * nq; sp = src + drow;
                wiq = true; dq = gptr((unsigned char*)(p.ws + WS_WAQ)) + (size_t)l * 1024 * 512; dqrow = drow; }
            else if (r < 640) { r -= 576; K = 512; N = 1024; kt = r >> 3; ntl = r & 7; src = gptr(p.s5_up) + (size_t)l * 512 * 1024; dst = gptr((bf16_t*)(p.ws + WS_WSU)) + (size_t)l * 1024 * 512; drow = ntl * 128 + 4 * nq; sp = src + drow;
                wiq = true; dq = gptr((unsigned char*)(p.ws + WS_WSUQ)) + (size_t)l * 1024 * 512; dqrow = drow; }
            else if (r < 672) { r -= 640; K = 512; N = 512; kt = r >> 2; ntl = r & 3; src = gptr(p.w_glu) + (size_t)l * 512 * 512; dst = gptr((bf16_t*)(p.ws + WS_WG)) + (size_t)l * 512 * 512; drow = ntl * 128 + 4 * nq; sp = src + drow; }
            else if (r < 800) { r -= 672; K = 1024; N = 1024; kt = r >> 3; ntl = r & 7; src = gptr(p.w_o) + (size_t)l * 1024 * 1024; dst = gptr((bf16_t*)(p.ws + WS_WO)) + (size_t)l * 1024 * 1024; drow = ntl * 128 + 4 * nq; sp = src + drow;
                wiq = true; dq = gptr((unsigned char*)(p.ws + WS_WOQ)) + (size_t)l * 1024 * 1024; dqrow = drow; }
            else if (r < 896) { r -= 800; K = 1024; N = 256; kt = r / 6; ntl = r % 6; dst = gptr((bf16_t*)(p.ws + WS_WRS)) + (size_t)l * 768 * 1024; drow = ntl * 128 + 4 * nq;
                if (ntl < 2) sp = gptr(p.w_router) + (size_t)l * 1024 * 256 + drow;
                else { const int n = 4 * nq, wcq = n >> 6, s = (n >> 5) & 1, rr = n & 31; sp = (s ? gptr(p.ws_up) : gptr(p.ws_gate)) + (size_t)l * 1024 * 256 + (ntl - 2) * 64 + 32 * wcq + rr;
                    wiq = true; dq = gptr((unsigned char*)(p.ws + WS_WSQ)) + (size_t)l * 512 * 1024; dqrow = drow - 256; } }
            else { r -= 896; K = 256; N = 1024; kt = r >> 3; ntl = r & 7; src = gptr(p.ws_down) + (size_t)l * 256 * 1024; dst = gptr((bf16_t*)(p.ws + WS_WSD)) + (size_t)l * 1024 * 256; drow = ntl * 128 + 4 * nq; sp = src + drow;
                wiq = true; dq = gptr((unsigned char*)(p.ws + WS_WSDQ)) + (size_t)l * 1024 * 256; dqrow = drow; }
            f32x4 v[8];
#pragma unroll
            for (int j = 0; j < 8; ++j) v[j] = *(const f32x4*)(sp + (size_t)(kt * 64 + kk * 8 + j) * N);
            if (wiq) {
#pragma unroll
                for (int ii = 0; ii < 4; ++ii) {
                    u32x2 o;
                    int d = __builtin_amdgcn_cvt_pk_fp8_f32(WIQ_SCALE * v[0][ii], WIQ_SCALE * v[1][ii], 0, false); o[0] = (unsigned)__builtin_amdgcn_cvt_pk_fp8_f32(WIQ_SCALE * v[2][ii], WIQ_SCALE * v[3][ii], d, true);
                    d = __builtin_amdgcn_cvt_pk_fp8_f32(WIQ_SCALE * v[4][ii], WIQ_SCALE * v[5][ii], 0, false); o[1] = (unsigned)__builtin_amdgcn_cvt_pk_fp8_f32(WIQ_SCALE * v[6][ii], WIQ_SCALE * v[7][ii], d, true);
                    *(u32x2*)(dq + (size_t)(dqrow + ii) * K + kt * 64 + kk * 8) = o;
                }
            } else {
#pragma unroll
            for (int ii = 0; ii < 4; ++ii) {
                u32x4 o; o[0] = cvt_pk_bf16(v[0][ii], v[1][ii]); o[1] = cvt_pk_bf16(v[2][ii], v[3][ii]); o[2] = cvt_pk_bf16(v[4][ii], v[5][ii]); o[3] = cvt_pk_bf16(v[6][ii], v[7][ii]);
                *(u32x4*)(dst + (size_t)(drow + ii) * K + kt * 64 + kk * 8) = o;
            }
            }
        }
    }
    float2* s_apow = (float2*)smem;
    float2* s_bbar = (float2*)(smem + 33 * 64 * 8);
    float2* s_c = (float2*)(smem + 33 * 64 * 8 + 8192);
    float* s_km = (float*)(smem + 33 * 64 * 8 + 16384);
    for (int u2 = b; u2 < 512; u2 += G) {
        const int u = u2 >> 3, sl = u2 & 7, l = u >> 5, g = u & 31;
        const float dtf = expf(gptr(p.log_dt)[l * 32 + g]);
        __syncthreads();
        for (int idx = t; idx < 33 * 64; idx += NTHR) {
            const int d = idx >> 6, n = idx & 63;
            const double lr = (double)gptr(p.lam_re)[(l * 32 + g) * 64 + n], li = (double)gptr(p.lam_im)[(l * 32 + g) * 64 + n];
            const double mag = exp(lr * (double)dtf * d); double sn, cn; sincos(li * (double)dtf * d, &sn, &cn);
            s_apow[idx] = make_float2((float)(mag * cn), (float)(mag * sn));
        }
        for (int idx = t; idx < 64 * 16; idx += NTHR) {
            const int n = idx >> 4, c = idx & 15;
            const float lr = gptr(p.lam_re)[(l * 32 + g) * 64 + n], li = gptr(p.lam_im)[(l * 32 + g) * 64 + n];
            const float mag = expf(lr * dtf); const float are = mag * cosf(li * dtf), aim = mag * sinf(li * dtf);
            const float den = lr * lr + li * li, nr = are - 1.f;
            const float cre = (nr * lr + aim * li) / den, cim = (aim * lr - nr * li) / den;
            const float br = gptr(p.b_re)[((size_t)(l * 32 + g) * 64 + n) * 16 + c], bi = gptr(p.b_im)[((size_t)(l * 32 + g) * 64 + n) * 16 + c];
            s_bbar[idx] = make_float2(cre * br - cim * bi, cre * bi + cim * br);
            const int cc = idx >> 6, nn = idx & 63;
            s_c[idx] = make_float2(gptr(p.c_re)[((size_t)(l * 32 + g) * 16 + cc) * 64 + nn], gptr(p.c_im)[((size_t)(l * 32 + g) * 16 + cc) * 64 + nn]);
        }
        __syncthreads();
        {
            float* km = gptr((float*)(p.ws + WS_KM)) + (size_t)u * 8192;
            for (int idx = t + sl * 1024; idx < (sl + 1) * 1024; idx += NTHR) {
                const int d = idx >> 8, c = (idx >> 4) & 15, c2 = idx & 15;
                float acc = 0.f;
                for (int n = 0; n < 64; ++n) {
                    const float2 a = s_apow[d * 64 + n], bb = s_bbar[n * 16 + c2], cv = s_c[c * 64 + n];
                    const float tr = a.x * bb.x - a.y * bb.y, ti = a.x * bb.y + a.y * bb.x;
                    acc += cv.x * tr - cv.y * ti;
                }
                km[idx] = acc;
            }
        }
        bf16_t* We = gptr((bf16_t*)(p.ws + WS_WE)) + (size_t)u * 128 * 512;
        for (int ch = t + sl * 1024; ch < (sl + 1) * 1024; ch += NTHR) {
            const int row = ch >> 6, c8 = ch & 63, ri = row >> 6, n = row & 63, j = c8 >> 1, cb = (c8 & 1) * 8;
            const float2 a = s_apow[(31 - j) * 64 + n];
            float v[8];
#pragma unroll
            for (int e = 0; e < 8; ++e) { const float2 bb = s_bbar[n * 16 + cb + e]; v[e] = ri ? (a.x * bb.y + a.y * bb.x) : (a.x * bb.x - a.y * bb.y); }
            u32x4 o; o[0] = cvt_pk_bf16(v[0], v[1]); o[1] = cvt_pk_bf16(v[2], v[3]); o[2] = cvt_pk_bf16(v[4], v[5]); o[3] = cvt_pk_bf16(v[6], v[7]);
            *(u32x4*)(We + (size_t)row * 512 + c8 * 8) = o;
        }
        bf16_t* Wc = gptr((bf16_t*)(p.ws + WS_WC)) + (size_t)u * 512 * 128;
        for (int ch = t + sl * 1024; ch < (sl + 1) * 1024; ch += NTHR) {
            const int row = ch >> 4, c8 = ch & 15, i = row >> 4, c = row & 15, ri = c8 >> 3, nb = (c8 & 7) * 8;
            float v[8];
#pragma unroll
            for (int e = 0; e < 8; ++e) { const int n = nb + e; const float2 a = s_apow[(i + 1) * 64 + n], cv = s_c[c * 64 + n];
                v[e] = ri ? -(cv.x * a.y + cv.y * a.x) : (cv.x * a.x - cv.y * a.y); }
            u32x4 o; o[0] = cvt_pk_bf16(v[0], v[1]); o[1] = cvt_pk_bf16(v[2], v[3]); o[2] = cvt_pk_bf16(v[4], v[5]); o[3] = cvt_pk_bf16(v[6], v[7]);
            *(u32x4*)(Wc + (size_t)row * 128 + c8 * 8) = o;
        }
        float2* aL = gptr((float2*)(p.ws + WS_AL)) + u * 64;
        if (t < 64 && sl == 0) aL[t] = s_apow[32 * 64 + t];
    }
}

static __device__ __forceinline__ void ph_inproj(CParams& p, int l, unsigned char* smem) {
    EPI_IDX;
    const bf16_t* xb = gptr((const bf16_t*)(p.ws + WS_XB));
    const bf16_t* Wt = gptr((const bf16_t*)(p.ws + WS_WI)) + (size_t)l * INC * D_;
    const unsigned char* xq = gptr((const unsigned char*)(p.ws + WS_XQ)); const unsigned char* Wq = gptr((const unsigned char*)(p.ws + WS_WIQ)) + (size_t)l * 4096 * 1024;
    const float2* cs = gptr((const float2*)(p.ws + WS_CS));
    bf16_t* qo = gptr((bf16_t*)(p.ws + WS_Q)); bf16_t* ko = gptr((bf16_t*)(p.ws + WS_K)); bf16_t* vto = gptr((bf16_t*)(p.ws + WS_VT));
    bf16_t* ugo = gptr((bf16_t*)(p.ws + WS_UG)); bf16_t* gao = gptr((bf16_t*)(p.ws + WS_GA)); bf16_t* gso = gptr((bf16_t*)(p.ws + WS_GS));
    const int G = gridDim.x, vb = vblock();
    TileSched ts; ts.init(vb, G, INC / 128);
    const bf16_t* pa_[4]; const bf16_t* pb_[4];
    if (ts.rank < ts.U) { int mt, nt; ts.get(ts.rank, mt, nt); __syncthreads(); gemm_dq_prefetch(pa_, pb_, smem, xq, D_, mt * 128, Wq, D_, nt * 128); }
    for (int u = ts.rank; u < ts.U; u += ts.R) {
        int mt, nt; ts.get(u, mt, nt);
        const int m0 = mt * 128, n0 = nt * 128;
        f32x4 acc[4][4]; zero_acc(acc);
        gemm_kloop_dd<true, true>(acc, smem, pa_, pb_, D_ / 128);
        if (u + ts.R < ts.U) { int mt2, nt2; ts.get(u + ts.R, mt2, nt2); gemm_dq_prefetch(pa_, pb_, smem, xq, D_, mt2 * 128, Wq, D_, nt2 * 128); }
        const int nw = n0 + 64 * _wc;
        if (nw < 1024) {
            const bool isq = nw < 512; const int hcol = nw & 511; bf16_t* dst = isq ? qo : ko; const float sc = (isq ? 0.125f : 1.f) / WIQ_SCALE;
#pragma unroll
            for (int i = 0; i < 4; ++i) {
                const int m = m0 + 64 * _wr + 16 * i + _l15;
#pragma unroll
                for (int j = 0; j < 2; ++j) {
                    const int f0 = 16 * j + 4 * _kg;
                    const f32x4 c01 = *(const f32x4*)(cs + (size_t)m * 32 + f0), c23 = *(const f32x4*)(cs + (size_t)m * 32 + f0 + 2);
                    const float cc[4] = {c01[0], c01[2], c23[0], c23[2]}, ss[4] = {c01[1], c01[3], c23[1], c23[3]};
                    float o1[4], o2[4];
#pragma unroll
                    for (int e = 0; e < 4; ++e) { const float t1 = acc[i][j][e], t2 = acc[i][j + 2][e]; o1[e] = (t1 * cc[e] - t2 * ss[e]) * sc; o2[e] = (t2 * cc[e] + t1 * ss[e]) * sc; }
                    st_bf16x4(dst + (size_t)m * 512 + hcol + f0, o1[0], o1[1], o1[2], o1[3]);
                    st_bf16x4(dst + (size_t)m * 512 + hcol + 32 + f0, o2[0], o2[1], o2[2], o2[3]);
                }
            }
        } else if (nw < 1536) {
            const int h = (nw - 1024) >> 6;
#pragma unroll
            for (int i = 0; i < 4; ++i) {
                const int m = m0 + 64 * _wr + 16 * i + _l15, bb = m >> 13, s = m & 8191;
#pragma unroll
                for (int j = 0; j < 4; ++j)
#pragma unroll
                    for (int e = 0; e < 4; ++e) { const int d = 16 * j + 4 * _kg + e; vto[((size_t)(bb * 8 + h) * 64 + d) * S_ + s] = f2bf(acc[i][j][e] * (1.f / WIQ_SCALE)); }
            }
        } else if (nw < 2048) {
            const int g0 = (nw - 1536) >> 4;
#pragma unroll
            for (int i = 0; i < 4; ++i) {
                const int m = m0 + 64 * _wr + 16 * i + _l15;
#pragma unroll
                for (int j = 0; j < 4; ++j) { const float qs = 1.f / WIQ_SCALE; st_bf16x4(ugo + ((size_t)(g0 + j) * T_ + m) * 16 + 4 * _kg, qs * acc[i][j][0], qs * acc[i][j][1], qs * acc[i][j][2], qs * acc[i][j][3]); }
            }
        } else {
            unsigned char* dst = (unsigned char*)((nw < 3072) ? gao : gso); const int c0 = (nw < 3072) ? nw - 2048 : nw - 3072;
#pragma unroll
            for (int i = 0; i < 4; ++i) {
                const int m = m0 + 64 * _wr + 16 * i + _l15;
#pragma unroll
                for (int j = 0; j < 4; ++j) { const float qs = 1.f / WIQ_SCALE; int d = __builtin_amdgcn_cvt_pk_fp8_f32(sigmoidf_(qs * acc[i][j][0]), sigmoidf_(qs * acc[i][j][1]), 0, false); d = __builtin_amdgcn_cvt_pk_fp8_f32(sigmoidf_(qs * acc[i][j][2]), sigmoidf_(qs * acc[i][j][3]), d, true);
                    *(int*)(dst + (size_t)m * 1024 + c0 + 16 * j + 4 * _kg) = d; }
            }
        }
    }
}

static __device__ __forceinline__ void toeplitz_unit(CParams& p, int l, int e, unsigned char* smem, int _t) {
            const int g = e >> 3, sl = e & 7, lg = l * 32 + g;
            float* s_km = (float*)smem;
            const float* km = gptr((const float*)(p.ws + WS_KM)) + (size_t)lg * 8192;
            __syncthreads();
            {
                const int wid = __builtin_amdgcn_readfirstlane(_t >> 6), lane = _t & 63;
                for (int c = wid; c < 4 * sl + 4; c += 4) dma16(km + c * 256 + lane * 4, smem + c * 1024);
                asm volatile("s_waitcnt vmcnt(0)" ::: "memory");
            }
            __syncthreads();
            bf16_t* Tm = gptr((bf16_t*)(p.ws + WS_TM)) + (size_t)lg * 512 * 512;
            const float* dsk = gptr(p.d_skip) + l * 512 + g * 16;
            for (int ch = _t + sl * 4096; ch < (sl + 1) * 4096; ch += NTHR) {
                const int row = ch >> 6, c8 = ch & 63;
                const int i = row >> 4, c = row & 15, j = c8 >> 1, cb = (c8 & 1) * 8;
                if (j > ((i >> 3) << 3) + 7) continue;
                float v[8];
#pragma unroll
                for (int ee = 0; ee < 8; ++ee) {
                    float x = 0.f;
                    if (j <= i) { x = s_km[((i - j) * 16 + c) * 16 + cb + ee]; if (i == j && c == cb + ee) x += dsk[c]; }
                    v[ee] = x;
                }
                u32x4 o; o[0] = cvt_pk_bf16(v[0], v[1]); o[1] = cvt_pk_bf16(v[2], v[3]); o[2] = cvt_pk_bf16(v[4], v[5]); o[3] = cvt_pk_bf16(v[6], v[7]);
                *(u32x4*)(Tm + (size_t)row * 512 + c8 * 8) = o;
            }
}

static __device__ __forceinline__ void ph_kmean_egemm(CParams& p, int l, unsigned char* smem) {
    EPI_IDX;
    const int G = gridDim.x, vb = vblock();
    const bf16_t* ko = gptr((const bf16_t*)(p.ws + WS_K));
    float* kmean = gptr((float*)(p.ws + WS_KMEAN));
    float* red = (float*)smem;
    const bool deal512 = (G == 512);
    const int loc = vb & 63, xc = vb >> 6; const bool isg = loc < 16;
    const int nitem = deal512 ? (isg ? 1 : 2) : (512 + 128 + 256 - vb + G - 1) / G;
    for (int it = 0; it < nitem; ++it) {
        int u;
        if (!deal512) { u = vb + it * G; }
        else if (isg) u = 512 + xc * 16 + loc;
        else { const int i = (xc * 48 + loc - 16) + it * 384; u = i < 256 ? 640 + i : i - 256; }
        if (u >= 640) {
            toeplitz_unit(p, l, u - 640, smem, _t);
        } else if (u < 512) {
            const int bh = u >> 5, j = u & 31, bb = bh >> 3, h = bh & 7;
            const int rg = _t >> 3, ch = _t & 7;
            const bf16_t* src = ko + ((size_t)(bb * S_ + j * 256 + rg)) * 512 + h * 64 + ch * 8;
            u32x4 v[8];
#pragma unroll
            for (int ps = 0; ps < 8; ++ps) v[ps] = *(const u32x4*)(src + (size_t)(ps * 32) * 512);
            float s8[8];
#pragma unroll
            for (int e = 0; e < 8; ++e) s8[e] = 0.f;
#pragma unroll
            for (int ps = 0; ps < 8; ++ps)
#pragma unroll
                for (int e = 0; e < 4; ++e) { s8[2 * e] += bflo(v[ps][e]); s8[2 * e + 1] += bfhi(v[ps][e]); }
            __syncthreads();
            *(f32x4*)(red + rg * 64 + ch * 8) = (f32x4){s8[0], s8[1], s8[2], s8[3]}; *(f32x4*)(red + rg * 64 + ch * 8 + 4) = (f32x4){s8[4], s8[5], s8[6], s8[7]};
            __syncthreads();
            if (_t < 64) { float s = 0.f;
#pragma unroll
                for (int r = 0; r < 32; ++r) s += red[r * 64 + _t];
                kmean[(size_t)u * 64 + _t] = s * (1.f / 256.f); }
        } else {
            const int e = u - 512, g = e >> 2, mt = e & 3, m0 = mt * 128;
            const bf16_t* A = gptr((const bf16_t*)(p.ws + WS_UG)) + (size_t)g * T_ * 16;
            const bf16_t* Bt = gptr((const bf16_t*)(p.ws + WS_WE)) + (size_t)(l * 32 + g) * 128 * 512;
            f32x4 acc[4][4]; zero_acc(acc);
            __syncthreads();
            gemm_dd(acc, smem, A, 512, m0, Bt, 512, 0, 512 / 64);
            float* E = gptr((float*)(p.ws + WS_E)) + (size_t)g * 512 * 128;
#pragma unroll
            for (int i = 0; i < 4; ++i) {
                const int m = m0 + 64 * _wr + 16 * i + _l15;
#pragma unroll
                for (int j = 0; j < 4; ++j) *(f32x4*)(E + (size_t)m * 128 + 64 * _wc + 16 * j + 4 * _kg) = acc[i][j];
            }
        }
    }
}

static __device__ __forceinline__ void ph_gate_scan(CParams& p, int l, unsigned char* smem) {
    const int G = gridDim.x, vb = vblock(), t = otid();
    const bf16_t* qo = gptr((const bf16_t*)(p.ws + WS_Q));
    const float* kmean = gptr((const float*)(p.ws + WS_KMEAN));
    int* tot = gptr((int*)(p.ws + WS_CTL + CTL_TOT)) + l * 512 * TOS;
    unsigned short* list = gptr((unsigned short*)(p.ws + WS_LIST));
    float* lse = gptr((float*)(p.ws + WS_LSE));
    float* s_km = (float*)smem;
    int* s_cnt = (int*)(smem + 8192);
    int* s_base = (int*)(smem + 8192 + 128);
    float2* s_he = (float2*)(smem + 8192 + 256);
    for (int u0 = vb; u0 < 512 + 256; u0 += G) {
        __syncthreads();
        const int u = (G == 512 && u0 < 512) ? ((u0 < 256) ? ((u0 >> 4) << 5) + (u0 & 15) : (((u0 - 256) >> 4) << 5) + 16 + ((u0 - 256) & 15)) : u0;
        if (u < 512) {
            const int bh = u >> 5, qb = u & 31, bb = bh >> 3, h = bh & 7;
            {
                const f32x4* kp = (const f32x4*)(kmean + (size_t)(bh * 32) * 64); const int n4 = qb * 16;
                f32x4 v0 = (f32x4){0.f, 0.f, 0.f, 0.f}, v1 = v0;
                if (t < n4) v0 = kp[t];
                if (t + NTHR < n4) v1 = kp[t + NTHR];
                if (t < n4) ((f32x4*)s_km)[t] = v0;
                if (t + NTHR < n4) ((f32x4*)s_km)[t + NTHR] = v1;
            }
            if (t < 32) s_cnt[t] = 0;
            __syncthreads();
            const int tok = bb * S_ + qb * 256 + t;
            float qv[64];
            {
                const u32x4* qp = (const u32x4*)(qo + (size_t)tok * 512 + h * 64);
#pragma unroll
                for (int c = 0; c < 8; ++c) { const u32x4 w = qp[c];
#pragma unroll
                    for (int e = 0; e < 4; ++e) { qv[c * 8 + 2 * e] = bflo(w[e]); qv[c * 8 + 2 * e + 1] = bfhi(w[e]); } }
            }
            float b0 = -3e38f, b1 = -3e38f, b2 = -3e38f; int i0 = 0, i1 = 0, i2 = 0;
            for (int j = 0; j < qb; ++j) {
                float g = 0.f;
#pragma unroll
                for (int d = 0; d < 64; ++d) g += qv[d] * s_km[j * 64 + d];
                if (g > b0) { b2 = b1; i2 = i1; b1 = b0; i1 = i0; b0 = g; i0 = j; }
                else if (g > b1) { b2 = b1; i2 = i1; b1 = g; i1 = j; }
                else if (g > b2) { b2 = g; i2 = j; }
            }
            const int nv = qb < 3 ? qb : 3;
            const int sel[3] = {i0, i1, i2};
            int pos[3];
#pragma unroll
            for (int s = 0; s < 3; ++s) {
                pos[s] = 0;
                if (s < nv) pos[s] = atomicAdd(&s_cnt[sel[s]], 1);
                else lse[((size_t)tok * 8 + h) * 4 + s] = NEG_INF;
            }
            __syncthreads();
            if (t < qb) { const int c = s_cnt[t]; s_base[t] = c > 0 ? atomicAdd(&tot[(t * 16 + bh) * TOS], c) : 0; }
            __syncthreads();
#pragma unroll
            for (int s = 0; s < 3; ++s)
                if (s < nv) list[(size_t)(bh * 32 + sel[s]) * 8192 + s_base[sel[s]] + pos[s]] = (unsigned short)((qb * 256 + t) | (s << 13));
        } else {
            const int e = u - 512, bb = e >> 7, g = (e >> 2) & 31, qr = e & 3, seg = t >> 4, nn = t & 15, n = qr * 16 + nn;
            const float* E = gptr((const float*)(p.ws + WS_E)) + ((size_t)g * 512 + bb * 256 + seg * 16) * 128;
            bf16_t* Hin = gptr((bf16_t*)(p.ws + WS_HIN)) + ((size_t)g * 512 + bb * 256 + seg * 16) * 128;
            const float2 a = (gptr((const float2*)(p.ws + WS_AL)))[(l * 32 + g) * 64 + n];
            float er[16], ei[16];
#pragma unroll
            for (int k = 0; k < 16; ++k) { er[k] = E[k * 128 + n]; ei[k] = E[k * 128 + 64 + n]; }
            float hr = 0.f, hi = 0.f;
#pragma unroll
            for (int k = 0; k < 16; ++k) { const float nr = a.x * hr - a.y * hi + er[k], ni = a.x * hi + a.y * hr + ei[k]; hr = nr; hi = ni; }
            s_he[seg * 16 + nn] = make_float2(hr, hi);
            float2 a16 = a;
#pragma unroll
            for (int k = 0; k < 4; ++k) a16 = make_float2(a16.x * a16.x - a16.y * a16.y, 2.f * a16.x * a16.y);
            __syncthreads();
            float cr = 0.f, ci = 0.f;
            for (int s = 0; s < seg; ++s) { const float2 he = s_he[s * 16 + nn]; const float nr = a16.x * cr - a16.y * ci + he.x, ni = a16.x * ci + a16.y * cr + he.y; cr = nr; ci = ni; }
            hr = cr; hi = ci;
#pragma unroll
            for (int k = 0; k < 16; ++k) {
                Hin[k * 128 + n] = f2bf(hr); Hin[k * 128 + 64 + n] = f2bf(hi);
                const float nr = a.x * hr - a.y * hi + er[k], ni = a.x * hi + a.y * hr + ei[k]; hr = nr; hi = ni;
            }
        }
    }
}

constexpr int AT_KS = 0;
constexpr int AT_VS = 32768;
constexpr int AT_UPRE = 32768 + 33280;
constexpr int AT_TOT = AT_UPRE + 2064;
constexpr int AT_MISC = AT_TOT + 2048;
constexpr int AT_NT = 8;

struct AttTile { int tok, slot, ql; bool valid; };

__device__ __forceinline__ void attn_unit(CParams& p, unsigned char* smem, int bh, int j, int sub, int nsel) {
    const int t = otid(), lane = t & 63, wid = t >> 6, l31 = lane & 31, hf = lane >> 5;
    const int bb = bh >> 3, h = bh & 7;
    const unsigned short* list = gptr((const unsigned short*)(p.ws + WS_LIST)) + (size_t)(bh * 32 + j) * 8192;
    const int ntiles = 8 + ((nsel + 31) >> 5);
    const int tile_lo = sub * AT_NT, tile_hi = (tile_lo + AT_NT < ntiles) ? tile_lo + AT_NT : ntiles;
    auto ent_load = [&](int tile) -> unsigned { if (tile < 8 || tile >= tile_hi) return 0u; const int idx = 32 * (tile - 8) + l31; return (unsigned)list[idx < nsel ? idx : 0]; };
    auto decode = [&](int tile, unsigned e) -> AttTile { AttTile a;
        if (tile < 8) { a.ql = 32 * tile + l31; a.tok = bb * S_ + j * 256 + a.ql; a.slot = 3; a.valid = true; }
        else { const int idx = 32 * (tile - 8) + l31; a.valid = (idx < nsel) && (tile < tile_hi); a.ql = 0; a.slot = (int)(e >> 13); a.tok = bb * S_ + (int)(e & 8191u); }
        return a; };
    const bf16_t* qg = gptr((const bf16_t*)(p.ws + WS_Q));
    const int tile0 = tile_lo + wid;
    unsigned e_a = ent_load(tile0), e_b = ent_load(tile0 + 4);
    {
        const bf16_t* ksrc = gptr((const bf16_t*)(p.ws + WS_K)) + ((size_t)(bb * S_ + j * 256)) * 512 + h * 64;
        u32x4 kv[8];
#pragma unroll
        for (int i = 0; i < 8; ++i) { const int idx = t + i * 256, row = idx >> 3, c = idx & 7; kv[i] = *(const u32x4*)(ksrc + (size_t)row * 512 + c * 8); }
        const bf16_t* vsrc = gptr((const bf16_t*)(p.ws + WS_VT)) + ((size_t)bh * 64) * S_ + j * 256;
        u32x4 vv[8];
#pragma unroll
        for (int i = 0; i < 8; ++i) { const int idx = t + i * 256, row = idx >> 5, c = idx & 31; vv[i] = *(const u32x4*)(vsrc + (size_t)row * S_ + c * 8); }
#pragma unroll
        for (int i = 0; i < 8; ++i) { const int idx = t + i * 256, row = idx >> 3, c = idx & 7; *(u32x4*)(smem + AT_KS + row * 128 + ((c ^ ((row >> 1) & 7)) << 4)) = kv[i]; }
#pragma unroll
        for (int i = 0; i < 8; ++i) { const int idx = t + i * 256, row = idx >> 5, c = idx & 31;
            u32x2 lo, hi2; lo[0] = vv[i][0]; lo[1] = vv[i][1]; hi2[0] = vv[i][2]; hi2[1] = vv[i][3];
            *(u32x2*)(smem + AT_VS + row * 520 + c * 16) = lo; *(u32x2*)(smem + AT_VS + row * 520 + c * 16 + 8) = hi2; }
    }
    AttTile cur = decode(tile0, e_a), nxt = decode(tile0 + 4, e_b);
    unsigned e_c = ent_load(tile0 + 8);
    bf16x8 qf[4];
#pragma unroll
    for (int s = 0; s < 4; ++s) qf[s] = *(const bf16x8*)(qg + (size_t)cur.tok * 512 + h * 64 + 16 * s + 8 * hf);
    __syncthreads();
    bf16_t* po = gptr((bf16_t*)(p.ws + WS_PO));
    float* lseo = gptr((float*)(p.ws + WS_LSE));
    for (int tile = tile0; tile < tile_hi; tile += 4) {
        bf16x8 qn[4];
#pragma unroll
        for (int s = 0; s < 4; ++s) qn[s] = *(const bf16x8*)(qg + (size_t)nxt.tok * 512 + h * 64 + 16 * s + 8 * hf);
        const unsigned e_d = ent_load(tile + 12);
        const bool own = tile < 8;
        const int ql = cur.ql;
        const int nkt = own ? tile + 1 : 8;
        f32x16 o0, o1;
#pragma unroll
        for (int r = 0; r < 16; ++r) { o0[r] = 0.f; o1[r] = 0.f; }
        float mrun = -3e38f, lrun = 0.f;
        for (int kt0 = 0; kt0 < nkt; kt0 += 2) {
            const bool has1 = (kt0 + 1 < nkt);
            f32x16 sacc[2];
#pragma unroll
            for (int kk = 0; kk < 2; ++kk) {
#pragma unroll
                for (int r = 0; r < 16; ++r) sacc[kk][r] = NEG_INF;
                if (kk == 0 || has1) {
                    f32x16 a;
#pragma unroll
                    for (int r = 0; r < 16; ++r) a[r] = 0.f;
                    const int krow = 32 * (kt0 + kk) + l31;
#pragma unroll
                    for (int s = 0; s < 4; ++s) {
                        const bf16x8 kf = *(const bf16x8*)(smem + AT_KS + krow * 128 + (((2 * s + hf) ^ ((krow >> 1) & 7)) << 4));
                        a = __builtin_amdgcn_mfma_f32_32x32x16_bf16(kf, qf[s], a, 0, 0, 0);
                    }
                    if (own) {
#pragma unroll
                        for (int r = 0; r < 16; ++r) { const int key = 32 * (kt0 + kk) + (r & 3) + 8 * (r >> 2) + 4 * hf; if (key > ql) a[r] = NEG_INF; }
                    }
                    sacc[kk] = a;
                }
            }
            float mx = mrun;
#pragma unroll
            for (int kk = 0; kk < 2; ++kk)
#pragma unroll
                for (int r = 0; r < 16; ++r) mx = fmaxf(mx, sacc[kk][r]);
            mx = fmaxf(mx, __shfl_xor(mx, 32));
            const float corr = __expf(mrun - mx);
            lrun *= corr;
#pragma unroll
            for (int r = 0; r < 16; ++r) { o0[r] *= corr; o1[r] *= corr; }
            mrun = mx;
#pragma unroll
            for (int kk = 0; kk < 2; ++kk) {
                if (kk == 0 || has1) {
                    float pv[16];
#pragma unroll
                    for (int r = 0; r < 16; ++r) { pv[r] = __expf(sacc[kk][r] - mx); lrun += pv[r]; }
#pragma unroll
                    for (int s = 0; s < 2; ++s) {
                        union { bf16x8 v; unsigned w[4]; } pf;
                        pf.w[0] = cvt_pk_bf16(pv[8 * s + 0], pv[8 * s + 1]); pf.w[1] = cvt_pk_bf16(pv[8 * s + 2], pv[8 * s + 3]);
                        pf.w[2] = cvt_pk_bf16(pv[8 * s + 4], pv[8 * s + 5]); pf.w[3] = cvt_pk_bf16(pv[8 * s + 6], pv[8 * s + 7]);
                        const int key0 = 32 * (kt0 + kk) + 16 * s + 4 * hf;
#pragma unroll
                        for (int dt = 0; dt < 2; ++dt) {
                            const unsigned char* vp = smem + AT_VS + (32 * dt + l31) * 520 + key0 * 2;
                            union { bf16x8 v; u32x2 h2[2]; } vf;
                            vf.h2[0] = *(const u32x2*)vp; vf.h2[1] = *(const u32x2*)(vp + 16);
                            if (dt == 0) o0 = __builtin_amdgcn_mfma_f32_32x32x16_bf16(vf.v, pf.v, o0, 0, 0, 0);
                            else o1 = __builtin_amdgcn_mfma_f32_32x32x16_bf16(vf.v, pf.v, o1, 0, 0, 0);
                        }
                    }
                }
            }
        }
        const float ltot = lrun + __shfl_xor(lrun, 32);
        const float inv = 1.f / ltot;
        if (cur.valid) {
            bf16_t* dst = po + (((size_t)cur.tok * 8 + h) * 4 + cur.slot) * 64;
#pragma unroll
            for (int g4 = 0; g4 < 4; ++g4) {
                st_bf16x4(dst + 8 * g4 + 4 * hf, o0[4 * g4] * inv, o0[4 * g4 + 1] * inv, o0[4 * g4 + 2] * inv, o0[4 * g4 + 3] * inv);
                st_bf16x4(dst + 32 + 8 * g4 + 4 * hf, o1[4 * g4] * inv, o1[4 * g4 + 1] * inv, o1[4 * g4 + 2] * inv, o1[4 * g4 + 3] * inv);
            }
            if (hf == 0) lseo[((size_t)cur.tok * 8 + h) * 4 + cur.slot] = mrun + __logf(ltot);
        }
        cur = nxt; nxt = decode(tile + 8, e_c); e_c = e_d;
#pragma unroll
        for (int s = 0; s < 4; ++s) qf[s] = qn[s];
    }
}

static __device__ __forceinline__ void ph_attn_ygemm(CParams& p, int l, unsigned char* smem) {
    EPI_IDX;
    const int G = gridDim.x, vb = vblock();
    for (int u = vb; u < 512; u += G) {
        const int g = u >> 4, mt = (u >> 2) & 3, nt = u & 3, m0 = mt * 128, n0 = nt * 128;
        const bf16_t* A1 = gptr((const bf16_t*)(p.ws + WS_UG)) + (size_t)g * T_ * 16;
        const bf16_t* B1 = gptr((const bf16_t*)(p.ws + WS_TM)) + (size_t)(l * 32 + g) * 512 * 512;
        const bf16_t* A2 = gptr((const bf16_t*)(p.ws + WS_HIN)) + (size_t)g * 512 * 128;
        const bf16_t* B2 = gptr((const bf16_t*)(p.ws + WS_WC)) + (size_t)(l * 32 + g) * 512 * 128;
        f32x4 acc[4][4]; zero_acc(acc);
        __syncthreads();
        gemm_dd(acc, smem, A1, 512, m0, B1, 512, n0, 2 * (nt + 1));
        gemm_dd(acc, smem, A2, 128, m0, B2, 128, n0, 2);
        bf16_t* z = gptr((bf16_t*)(p.ws + WS_Z));
#pragma unroll
        for (int i = 0; i < 4; ++i) {
            const int m = m0 + 64 * _wr + 16 * i + _l15;
#pragma unroll
            for (int j = 0; j < 4; ++j) {
                const int n = n0 + 64 * _wc + 16 * j, ii = n >> 4;
                st_bf16x4(z + (size_t)(32 * m + ii) * 512 + g * 16 + 4 * _kg, gelu_tanh(acc[i][j][0]), gelu_tanh(acc[i][j][1]), gelu_tanh(acc[i][j][2]), gelu_tanh(acc[i][j][3]));
            }
        }
    }
    int* s_upre = (int*)(smem + AT_UPRE); int* s_tot = (int*)(smem + AT_TOT); int* s_u = (int*)(smem + AT_MISC);
    const int* tot = gptr((const int*)(p.ws + WS_CTL + CTL_TOT)) + l * 512 * TOS;
    __syncthreads();
    {
        const int c0 = tot[(2 * _t) * TOS], c1 = tot[(2 * _t + 1) * TOS];
        const int v0 = (8 + ((c0 + 31) >> 5) + AT_NT - 1) / AT_NT, v1 = (8 + ((c1 + 31) >> 5) + AT_NT - 1) / AT_NT;
        s_tot[2 * _t] = c0; s_tot[2 * _t + 1] = c1;
        int inc = v0 + v1;
#pragma unroll
        for (int o = 1; o < 64; o <<= 1) { const int y = __shfl_up(inc, o); if (_lane >= o) inc += y; }
        if (_lane == 63) s_u[_wid] = inc;
        __syncthreads();
        const int w0 = s_u[0], w1 = s_u[1], w2 = s_u[2], w3 = s_u[3];
        const int ex = inc - (v0 + v1) + (_wid > 0 ? w0 : 0) + (_wid > 1 ? w1 : 0) + (_wid > 2 ? w2 : 0);
        s_upre[2 * _t] = ex; s_upre[2 * _t + 1] = ex + v0;
        if (_t == 0) s_upre[512] = w0 + w1 + w2 + w3;
    }
    __syncthreads();
    const int total = s_upre[512];
    int* qctr = gptr((int*)(p.ws + WS_CTL + CTL_ATTQ + 256 * l));
    for (;;) {
        __syncthreads();
        if (_t == 0) *s_u = atomicAdd(qctr, 1);
        __syncthreads();
        const int u = *s_u;
        if (u >= total) break;
        int lo = 0, hi = 511;
        while (lo < hi) { const int mid = (lo + hi + 1) >> 1; if (s_upre[mid] <= u) lo = mid; else hi = mid - 1; }
        attn_unit(p, smem, lo & 15, lo >> 4, u - s_upre[lo], s_tot[lo]);
    }
}

static __device__ __forceinline__ void ph_combine_glu(CParams& p, int l, unsigned char* smem) {
    EPI_IDX;
    const int G = gridDim.x, vb = vblock();
    {
        const float* lse = gptr((const float*)(p.ws + WS_LSE)); const bf16_t* po = gptr((const bf16_t*)(p.ws + WS_PO)); unsigned char* ao = gptr((unsigned char*)(p.ws + WS_AO));
#pragma unroll 2
        for (int idx = obid() * NTHR + _t; idx < T_ * 8 * 8; idx += G * NTHR) {
            const int th = idx >> 3, c = idx & 7;
            const f32x4 ls = *(const f32x4*)(lse + (size_t)th * 4);
            u32x4 pv[4];
#pragma unroll
            for (int s = 0; s < 4; ++s) pv[s] = *(const u32x4*)(po + ((size_t)th * 4 + s) * 64 + c * 8);
            const float mx = fmaxf(fmaxf(ls[0], ls[1]), fmaxf(ls[2], ls[3]));
            float w[4], ws = 0.f;
#pragma unroll
            for (int s = 0; s < 4; ++s) { w[s] = (ls[s] > -1e29f) ? __expf(ls[s] - mx) : 0.f; ws += w[s]; }
            const float inv = 1.f / ws;
            float o[8];
#pragma unroll
            for (int e = 0; e < 8; ++e) o[e] = 0.f;
#pragma unroll
            for (int s = 0; s < 4; ++s) {
                {
                    const bool on = w[s] > 0.f;
                    const u32x4 v = pv[s];
                    const float ww = w[s] * inv;
#pragma unroll
                    for (int e = 0; e < 4; ++e) { o[2 * e] += on ? ww * bflo(v[e]) : 0.f; o[2 * e + 1] += on ? ww * bfhi(v[e]) : 0.f; }
                }
            }
            u32x2 ov; int d = __builtin_amdgcn_cvt_pk_fp8_f32(o[0], o[1], 0, false); ov[0] = (unsigned)__builtin_amdgcn_cvt_pk_fp8_f32(o[2], o[3], d, true);
            d = __builtin_amdgcn_cvt_pk_fp8_f32(o[4], o[5], 0, false); ov[1] = (unsigned)__builtin_amdgcn_cvt_pk_fp8_f32(o[6], o[7], d, true);
            *(u32x2*)(ao + (size_t)th * 64 + c * 8) = ov;
        }
    }
    const bf16_t* z = gptr((const bf16_t*)(p.ws + WS_Z));
    const bf16_t* Wt = gptr((const bf16_t*)(p.ws + WS_WG)) + (size_t)l * 512 * 512; const float* bg = gptr(p.b_glu) + l * 512;
    unsigned char* sgl = gptr((unsigned char*)(p.ws + WS_SGL));
    TileSched ts; ts.init(vb, G, 4);
    for (int u = ts.rank; u < ts.U; u += ts.R) {
        int mt, nt; ts.get(u, mt, nt);
        const int m0 = mt * 128, n0 = nt * 128;
        f32x4 acc[4][4]; zero_acc(acc);
        __syncthreads();
        gemm_dd(acc, smem, z, 512, m0, Wt, 512, n0, 8);
#pragma unroll
        for (int i = 0; i < 4; ++i) {
            const int m = m0 + 64 * _wr + 16 * i + _l15;
#pragma unroll
            for (int j = 0; j < 4; ++j) {
                const int n = n0 + 64 * _wc + 16 * j + 4 * _kg;
                const u32x2 zz = *(const u32x2*)(z + (size_t)m * 512 + n);
                const f32x4 bv = *(const f32x4*)(bg + n);
                const float z0 = bflo(zz[0]), z1 = bfhi(zz[0]), z2 = bflo(zz[1]), z3 = bfhi(zz[1]);
                int d = __builtin_amdgcn_cvt_pk_fp8_f32(z0 * sigmoidf_(acc[i][j][0] + bv[0]), z1 * sigmoidf_(acc[i][j][1] + bv[1]), 0, false);
                d = __builtin_amdgcn_cvt_pk_fp8_f32(z2 * sigmoidf_(acc[i][j][2] + bv[2]), z3 * sigmoidf_(acc[i][j][3] + bv[3]), d, true);
                *(int*)(sgl + (size_t)m * 512 + n) = d;
            }
        }
    }
}

static __device__ __forceinline__ void ph_merge(CParams& p, int l, unsigned char* smem) {
    EPI_IDX;
    const int G = gridDim.x, vb = vblock();
    const bf16_t* ao = gptr((const bf16_t*)(p.ws + WS_AO)); const bf16_t* sgl = gptr((const bf16_t*)(p.ws + WS_SGL));
    const unsigned char* ga = gptr((const unsigned char*)(p.ws + WS_GA)); const unsigned char* gs = gptr((const unsigned char*)(p.ws + WS_GS));
    const bf16_t* Wa = (const bf16_t*)(gptr((const unsigned char*)(p.ws + WS_WAQ)) + (size_t)l * 1024 * 512); const bf16_t* Ws = (const bf16_t*)(gptr((const unsigned char*)(p.ws + WS_WSUQ)) + (size_t)l * 1024 * 512);
    unsigned char* mix = gptr((unsigned char*)(p.ws + WS_MIX));
    TileSched ts; ts.init(vb, G, 8);
    for (int u = ts.rank; u < ts.U; u += ts.R) {
        int mt, nt; ts.get(u, mt, nt);
        const int m0 = mt * 128, n0 = nt * 128;
        f32x4 acca[4][4], accs[4][4]; zero_acc(acca); zero_acc(accs);
        __syncthreads();
        gemm_dd_seq<true>(acca, accs, smem, ao, 256, Wa, 256, 4, sgl, 256, Ws, 256, 4, m0, n0);
#pragma unroll
        for (int i = 0; i < 4; ++i) {
            const int m = m0 + 64 * _wr + 16 * i + _l15;
#pragma unroll
            for (int j = 0; j < 4; ++j) {
                const int n = n0 + 64 * _wc + 16 * j + 4 * _kg;
                const int a4 = *(const int*)(ga + (size_t)m * 1024 + n), s4 = *(const int*)(gs + (size_t)m * 1024 + n);
                const f32x2v alo = __builtin_amdgcn_cvt_pk_f32_fp8(a4, false), ahi = __builtin_amdgcn_cvt_pk_f32_fp8(a4, true);
                const f32x2v slo = __builtin_amdgcn_cvt_pk_f32_fp8(s4, false), shi = __builtin_amdgcn_cvt_pk_f32_fp8(s4, true);
                const float qs = 1.f / WIQ_SCALE;
                int d = __builtin_amdgcn_cvt_pk_fp8_f32(qs * (alo[0] * acca[i][j][0] + slo[0] * accs[i][j][0]), qs * (alo[1] * acca[i][j][1] + slo[1] * accs[i][j][1]), 0, false);
                d = __builtin_amdgcn_cvt_pk_fp8_f32(qs * (ahi[0] * acca[i][j][2] + shi[0] * accs[i][j][2]), qs * (ahi[1] * acca[i][j][3] + shi[1] * accs[i][j][3]), d, true);
                *(int*)(mix + (size_t)m * 1024 + n) = d;
            }
        }
    }
}

static __device__ __forceinline__ void ph_outproj(CParams& p, int l, unsigned char* smem) {
    EPI_IDX;
    const int G = gridDim.x, vb = vblock();
    const unsigned char* mix = gptr((const unsigned char*)(p.ws + WS_MIX));
    const unsigned char* Wq = gptr((const unsigned char*)(p.ws + WS_WOQ)) + (size_t)l * 1024 * 1024;
    const bf16_t* xres = gptr((const bf16_t*)(p.ws + WS_XB));
    bf16_t* y1 = gptr((bf16_t*)(p.ws + WS_Y1));
    TileSched ts; ts.init(vb, G, 8);
    for (int u = ts.rank; u < ts.U; u += ts.R) {
        int mt, nt; ts.get(u, mt, nt);
        const int m0 = mt * 128, n0 = nt * 128;
        f32x4 acc[4][4]; zero_acc(acc);
        __syncthreads();
        gemm_dq(acc, smem, mix, 1024, m0, Wq, 1024, n0, 8);
#pragma unroll
        for (int i = 0; i < 4; ++i) {
            const int m = m0 + 64 * _wr + 16 * i + _l15;
#pragma unroll
            for (int j = 0; j < 4; ++j) {
                const int n = n0 + 64 * _wc + 16 * j + 4 * _kg;
                const u32x2 xr = *(const u32x2*)(xres + (size_t)m * 1024 + n);
                const float qs = 1.f / WIQ_SCALE;
                st_bf16x4(y1 + (size_t)m * 1024 + n, bflo(xr[0]) * DN_ALPHA + qs * acc[i][j][0], bfhi(xr[0]) * DN_ALPHA + qs * acc[i][j][1], bflo(xr[1]) * DN_ALPHA + qs * acc[i][j][2], bfhi(xr[1]) * DN_ALPHA + qs * acc[i][j][3]);
            }
        }
    }
}

template <bool MOE>
static __device__ __forceinline__ void ph_layernorm(CParams& p, const bf16_t* src, const float* gam, const float* bet, float* dstf, bf16_t* dstb, unsigned char* dstq = nullptr) {
    const int G = gridDim.x, t = otid(), lane = t & 63, wid = t >> 6;
    const unsigned char* yb = gptr((const unsigned char*)(p.ws + WS_YBUF));
    for (int row = obid() * 4 + wid; row < T_; row += G * 4) {
        float v[16];
#pragma unroll
        for (int c = 0; c < 2; ++c) { const u32x4 x = *(const u32x4*)(src + (size_t)row * 1024 + c * 512 + lane * 8);
#pragma unroll
            for (int e = 0; e < 4; ++e) { v[8 * c + 2 * e] = bflo(x[e]); v[8 * c + 2 * e + 1] = bfhi(x[e]); } }
        if (MOE) {
#pragma unroll
            for (int k = 0; k < 8; ++k)
#pragma unroll
                for (int c = 0; c < 2; ++c) { const u32x2 y = *(const u32x2*)(yb + ((size_t)row * 8 + k) * 1024 + c * 512 + lane * 8);
#pragma unroll
                    for (int e = 0; e < 2; ++e) { const f32x2v lo = __builtin_amdgcn_cvt_pk_f32_bf8((int)y[e], false), hi = __builtin_amdgcn_cvt_pk_f32_bf8((int)y[e], true);
                        v[8 * c + 4 * e] += lo[0]; v[8 * c + 4 * e + 1] += lo[1]; v[8 * c + 4 * e + 2] += hi[0]; v[8 * c + 4 * e + 3] += hi[1]; } }
        }
        float s = 0.f;
#pragma unroll
        for (int e = 0; e < 16; ++e) s += v[e];
#pragma unroll
        for (int o = 32; o >= 1; o >>= 1) s += __shfl_xor(s, o);
        const float mu = s * (1.f / 1024.f);
        float q = 0.f;
#pragma unroll
        for (int e = 0; e < 16; ++e) { v[e] -= mu; q += v[e] * v[e]; }
#pragma unroll
        for (int o = 32; o >= 1; o >>= 1) q += __shfl_xor(q, o);
        const float rs = rsqrtf(q * (1.f / 1024.f) + LN_EPS);
#pragma unroll
        for (int c = 0; c < 2; ++c) {
            float o[8];
#pragma unroll
            for (int h = 0; h < 2; ++h) { const f32x4 gg = *(const f32x4*)(gam + c * 512 + lane * 8 + 4 * h), bb = *(const f32x4*)(bet + c * 512 + lane * 8 + 4 * h);
#pragma unroll
                for (int e = 0; e < 4; ++e) o[4 * h + e] = v[8 * c + 4 * h + e] * rs * gg[e] + bb[e]; }
            if (dstf) { *(f32x4*)(dstf + (size_t)row * 1024 + c * 512 + lane * 8) = (f32x4){o[0], o[1], o[2], o[3]}; *(f32x4*)(dstf + (size_t)row * 1024 + c * 512 + lane * 8 + 4) = (f32x4){o[4], o[5], o[6], o[7]}; }
            if (dstb) { u32x4 w; w[0] = cvt_pk_bf16(o[0], o[1]); w[1] = cvt_pk_bf16(o[2], o[3]); w[2] = cvt_pk_bf16(o[4], o[5]); w[3] = cvt_pk_bf16(o[6], o[7]); *(u32x4*)(dstb + (size_t)row * 1024 + c * 512 + lane * 8) = w; }
            if (dstq) { u32x2 w; int d = __builtin_amdgcn_cvt_pk_fp8_f32(o[0], o[1], 0, false); w[0] = (unsigned)__builtin_amdgcn_cvt_pk_fp8_f32(o[2], o[3], d, true); d = __builtin_amdgcn_cvt_pk_fp8_f32(o[4], o[5], 0, false); w[1] = (unsigned)__builtin_amdgcn_cvt_pk_fp8_f32(o[6], o[7], d, true); *(u32x2*)(dstq + (size_t)row * 1024 + c * 512 + lane * 8) = w; }
        }
    }
}

static __device__ __forceinline__ void ph_router_shared1(CParams& p, int l, unsigned char* smem) {
    EPI_IDX;
    const int G = gridDim.x, vb = vblock();
    const bf16_t* x1b = gptr((const bf16_t*)(p.ws + WS_X1B));
    const bf16_t* Wt = gptr((const bf16_t*)(p.ws + WS_WRS)) + (size_t)l * 768 * 1024;
    const unsigned char* x1q = gptr((const unsigned char*)(p.ws + WS_X1Q)); const unsigned char* Wq = gptr((const unsigned char*)(p.ws + WS_WSQ)) + (size_t)l * 512 * 1024;
    TileSched ts; ts.init(vb, G, 6);
    for (int ui = ts.rank; ui < 64; ui += ts.R) {
      const int mt = 16 * ts.x + (ui & 15), kind = ui >> 4;
      for (int sub = 0; sub < (kind < 2 ? 1 : 2); ++sub) {
        const int nt = kind < 2 ? kind : 2 + 2 * (kind - 2) + sub;
        const int m0 = mt * 128, n0 = nt * 128;
        f32x4 acc[4][4]; zero_acc(acc);
        __syncthreads();
        if (nt < 2) gemm_dd(acc, smem, x1b, 1024, m0, Wt, 1024, n0, 16);
        else gemm_dq(acc, smem, x1q, 1024, m0, Wq, 1024, n0 - 256, 8);
        if (nt < 2) {
            float* sc = gptr((float*)(p.ws + WS_SC));
#pragma unroll
            for (int i = 0; i < 4; ++i) {
                const int m = m0 + 64 * _wr + 16 * i + _l15;
#pragma unroll
                for (int j = 0; j < 4; ++j) { f32x4 o; o[0] = sigmoidf_(acc[i][j][0]); o[1] = sigmoidf_(acc[i][j][1]); o[2] = sigmoidf_(acc[i][j][2]); o[3] = sigmoidf_(acc[i][j][3]);
                    *(f32x4*)(sc + (size_t)m * 256 + n0 + 64 * _wc + 16 * j + 4 * _kg) = o; }
            }
        } else {
            const int c0 = (nt - 2) * 64;
            unsigned char* hs = gptr((unsigned char*)(p.ws + WS_HS));
#pragma unroll
            for (int i = 0; i < 4; ++i) {
                const int m = m0 + 64 * _wr + 16 * i + _l15;
#pragma unroll
                for (int j = 0; j < 2; ++j) { const float qs = 1.f / WIQ_SCALE;
                    int d = __builtin_amdgcn_cvt_pk_fp8_f32(siluf_(qs * acc[i][j][0]) * (qs * acc[i][j + 2][0]), siluf_(qs * acc[i][j][1]) * (qs * acc[i][j + 2][1]), 0, false);
                    d = __builtin_amdgcn_cvt_pk_fp8_f32(siluf_(qs * acc[i][j][2]) * (qs * acc[i][j + 2][2]), siluf_(qs * acc[i][j][3]) * (qs * acc[i][j + 2][3]), d, true);
                    *(int*)(hs + (size_t)m * 256 + c0 + 32 * _wc + 16 * j + 4 * _kg) = d; }
            }
        }
      }
    }
}

static __device__ __forceinline__ void ph_route_shared2(CParams& p, int l, unsigned char* smem) {
    EPI_IDX;
    const int G = gridDim.x, vb = vblock();
    int* s_ae = (int*)smem;
    float* s_aw = (float*)(smem + 1024);
    int* ecnt = gptr((int*)(p.ws + WS_CTL + CTL_ECNT)) + l * 256 * ECS;
    int2* rowl = gptr((int2*)(p.ws + WS_ROWL));
    const float* sc = gptr((const float*)(p.ws + WS_SC));
    const float* rb = gptr(p.router_bias) + l * 256;
    const int nit = (512 + 1024 - vb + G - 1) / G;
    for (int it = 0; it < nit; ++it) {
        const int u = vb + ((it + vb) % nit) * G;
        if (u < 512) {
            __syncthreads();
            const unsigned long long lt_mask = (1ull << _lane) - 1ull;
            for (int it = 0; it < 8; ++it) {
                const int tl = _wid * 8 + it, tok = u * 32 + tl;
                const f32x4 s4 = *(const f32x4*)(sc + (size_t)tok * 256 + _lane * 4);
                const f32x4 b4 = *(const f32x4*)(rb + _lane * 4);
                float bs[4] = {s4[0] + b4[0], s4[1] + b4[1], s4[2] + b4[2], s4[3] + b4[3]};
                float m1 = fmaxf(bs[0], bs[1]), m2 = fminf(bs[0], bs[1]);
                { const float v = bs[2]; if (v > m1) { m2 = m1; m1 = v; } else if (v > m2) m2 = v; }
                { const float v = bs[3]; if (v > m1) { m2 = m1; m1 = v; } else if (v > m2) m2 = v; }
#pragma unroll
                for (int o = 1; o <= 4; o <<= 1) { const float o1 = __shfl_xor(m1, o), o2 = __shfl_xor(m2, o); const float n1 = fmaxf(m1, o1), n2 = fmaxf(fminf(m1, o1), fmaxf(m2, o2)); m1 = n1; m2 = n2; }
                const float gsc = m1 + m2; const int mygrp = _lane >> 3;
                int rank = 0;
#pragma unroll
                for (int g2 = 0; g2 < 8; ++g2) { const float og = __int_as_float(__builtin_amdgcn_readlane(__float_as_int(gsc), g2 * 8)); rank += (og > gsc || (og == gsc && g2 < mygrp)) ? 1 : 0; }
                const bool gsel = rank < 4;
                unsigned key[4];
#pragma unroll
                for (int e = 0; e < 4; ++e) { const unsigned bits = __float_as_uint(bs[e]); key[e] = gsel ? (bits ^ ((bits >> 31) ? 0xFFFFFFFFu : 0x80000000u)) : 0u; }
                unsigned T = 0u;
                for (int bit = 31; bit >= 0; --bit) {
                    const unsigned cand = T | (1u << bit);
                    int c = 0;
#pragma unroll
                    for (int e = 0; e < 4; ++e) c += __popcll(__ballot(key[e] >= cand));
                    if (c >= 8) { T = cand; if (c == 8) break; }
                }
                int ngt = 0;
#pragma unroll
                for (int e = 0; e < 4; ++e) ngt += __popcll(__ballot(key[e] > T));
                unsigned long long beq[4];
#pragma unroll
                for (int e = 0; e < 4; ++e) beq[e] = __ballot(key[e] == T);
                int eq_before = 0;
#pragma unroll
                for (int e = 0; e < 4; ++e) eq_before += __popcll(beq[e] & lt_mask);
                bool sel[4]; int eqm = 0;
#pragma unroll
                for (int e = 0; e < 4; ++e) { const bool isgt = key[e] > T, iseq = key[e] == T; sel[e] = isgt || (iseq && (ngt + eq_before + eqm < 8)); eqm += iseq ? 1 : 0; }
                unsigned long long bsel[4];
#pragma unroll
                for (int e = 0; e < 4; ++e) bsel[e] = __ballot(sel[e]);
                int kidx = 0;
#pragma unroll
                for (int e = 0; e < 4; ++e) kidx += __popcll(bsel[e] & lt_mask);
#pragma unroll
                for (int e = 0; e < 4; ++e) if (sel[e]) { s_ae[tl * 8 + kidx] = _lane * 4 + e; s_aw[tl * 8 + kidx] = s4[e]; ++kidx; }
            }
            __syncthreads();
            {
                const int a = _t, tl = a >> 3, e = s_ae[a];
                float wsum = 0.f;
#pragma unroll
                for (int k = 0; k < 8; ++k) wsum += s_aw[tl * 8 + k];
                const float w = s_aw[a] / wsum * 2.5f;
                const int pos = atomicAdd(&ecnt[e * ECS], 1);
                rowl[(size_t)e * 16384 + pos] = make_int2((u * 32 + tl) * 8 + (a & 7), __float_as_int(w));
            }
        } else {
            const int e = u - 512, mt = e >> 3, nt = e & 7, m0 = mt * 128, n0 = nt * 128;
            const unsigned char* hs = gptr((const unsigned char*)(p.ws + WS_HS));
            const unsigned char* Wq = gptr((const unsigned char*)(p.ws + WS_WSDQ)) + (size_t)l * 1024 * 256;
            f32x4 acc[4][4]; zero_acc(acc);
            __syncthreads();
            gemm_dq(acc, smem, hs, 256, m0, Wq, 256, n0, 2);
            const bf16_t* x1r = gptr((const bf16_t*)(p.ws + WS_X1B)); bf16_t* y2 = gptr((bf16_t*)(p.ws + WS_Y1));
#pragma unroll
            for (int i = 0; i < 4; ++i) {
                const int m = m0 + 64 * _wr + 16 * i + _l15;
#pragma unroll
                for (int j = 0; j < 4; ++j) {
                    const int n = n0 + 64 * _wc + 16 * j + 4 * _kg;
                    const u32x2 xr = *(const u32x2*)(x1r + (size_t)m * 1024 + n);
                    const float qs = 1.f / WIQ_SCALE;
                    st_bf16x4(y2 + (size_t)m * 1024 + n, bflo(xr[0]) * DN_ALPHA + qs * acc[i][j][0], bfhi(xr[0]) * DN_ALPHA + qs * acc[i][j][1], bflo(xr[1]) * DN_ALPHA + qs * acc[i][j][2], bfhi(xr[1]) * DN_ALPHA + qs * acc[i][j][3]);
                }
            }
        }
    }
}

struct ExpPre { int mypre, total, rowpre; };
__device__ __forceinline__ ExpPre expert_prefix(const int* ecnt, unsigned char* smem, int ntile_per_rb, int rows_per_unit) {
    const int t = otid(), lane = t & 63, wid = t >> 6;
    int* sx = (int*)smem;
    const int c = ecnt[t * ECS];
    const int v = ((c + rows_per_unit - 1) / rows_per_unit) * ntile_per_rb;
    int inc = v, rinc = c;
#pragma unroll
    for (int o = 1; o < 64; o <<= 1) { const int y = __shfl_up(inc, o), yr = __shfl_up(rinc, o); if (lane >= o) { inc += y; rinc += yr; } }
    __syncthreads();
    if (lane == 63) { sx[wid] = inc; sx[4 + wid] = rinc; }
    __syncthreads();
    const int t0 = sx[0], t1 = sx[1], t2 = sx[2], t3 = sx[3], r0 = sx[4], r1 = sx[5], r2 = sx[6];
    ExpPre r; r.mypre = inc - v + (wid > 0 ? t0 : 0) + (wid > 1 ? t1 : 0) + (wid > 2 ? t2 : 0); r.total = t0 + t1 + t2 + t3;
    r.rowpre = rinc - c + (wid > 0 ? r0 : 0) + (wid > 1 ? r1 : 0) + (wid > 2 ? r2 : 0);
    __syncthreads();
    return r;
}
__device__ __forceinline__ void expert_find(const ExpPre& ep, unsigned char* smem, int u, int& e, int& start) {
    const int t = otid(), lane = t & 63, wid = t >> 6;
    int* sx = (int*)smem;
    const int cw = __popcll(__ballot(ep.mypre <= u));
    const int sw_ = __shfl(ep.mypre, cw > 0 ? cw - 1 : 0);
    __syncthreads();
    if (lane == 0) { sx[2 * wid] = cw; sx[2 * wid + 1] = cw > 0 ? sw_ : -1; }
    __syncthreads();
    const int c0 = sx[0], c1 = sx[2], c2 = sx[4], c3 = sx[6];
    e = __builtin_amdgcn_readfirstlane(c0 + c1 + c2 + c3 - 1);
    int s = sx[1]; s = sx[3] > s ? sx[3] : s; s = sx[5] > s ? sx[5] : s; s = sx[7] > s ? sx[7] : s;
    start = __builtin_amdgcn_readfirstlane(s);
    __syncthreads();
}

static __device__ __forceinline__ void ph_expert1(CParams& p, int l, unsigned char* smem) {
    EPI_IDX;
    const int G = gridDim.x, vb = vblock();
    const int* ecnt = gptr((const int*)(p.ws + WS_CTL + CTL_ECNT)) + l * 256 * ECS;
    const ExpPre ep = expert_prefix(ecnt, smem, 4, 256);
    const int total = ep.total;
    int* rbase = gptr((int*)(p.ws + WS_CTL + CTL_RBASE)) + l * 256;
    rbase[_t] = ep.rowpre;
    __syncthreads();
    const int2* rowl = gptr((const int2*)(p.ws + WS_ROWL));
    const unsigned char* x1q = gptr((const unsigned char*)(p.ws + WS_X1Q));
    unsigned char* hq = gptr((unsigned char*)(p.ws + WS_HBUF));
    const int sw = (_l15 >> 1) & 7;
    const int ra0 = (_wr * 64 + _l15) * 128 + (((0 + _kg) ^ sw) << 4), ra1 = (_wr * 64 + _l15) * 128 + (((4 + _kg) ^ sw) << 4);
    const int rb0 = (_wc * 64 + _l15) * 128 + (((0 + _kg) ^ sw) << 4), rb1 = (_wc * 64 + _l15) * 128 + (((4 + _kg) ^ sw) << 4);
    const int wid_u = __builtin_amdgcn_readfirstlane(_wid);
    unsigned char* wbase = smem + wid_u * 4096;
    unsigned char* Bst = smem + 65536;
    constexpr float W1Q = 64.f;
    const int bq_ = _t & 31, kc = _t >> 5;
    const int wcq = bq_ >> 4, smat = (bq_ >> 3) & 1, rr2 = 8 * (bq_ & 3) + 4 * ((bq_ >> 2) & 1);
    for (int u = vb; u < total; u += G) {
        int e, ustart; expert_find(ep, smem, u, e, ustart);
        const int cnt = __builtin_amdgcn_readfirstlane(ecnt[e * ECS]), npr = (cnt + 255) >> 8, r = u - ustart, nt = r / npr, pr = r % npr, c0 = nt * 64;
        const int hrow0 = __builtin_amdgcn_readfirstlane(rbase[e]) + pr * 256;
        const int2* rl = rowl + (size_t)e * 16384 + pr * 256;
        const int nrows = cnt - pr * 256;
        const bool has1 = nrows > 128;
        unsigned ap0[4], ap1[4];
#pragma unroll
        for (int q = 0; q < 4; ++q) { int rr = dma_row(_t, q); int r0 = rr < nrows ? rr : 0, r1 = 128 + rr < nrows ? 128 + rr : 0;
            const int a0 = rl[r0].x, a1 = rl[r1].x; ap0[q] = (unsigned)(a0 >> 3) * 1024u + 2u * dma_koff(_t, q); ap1[q] = (unsigned)(a1 >> 3) * 1024u + 2u * dma_koff(_t, q); }
        const float* wbase_e = (smat ? gptr(p.w_up_e) : gptr(p.w_gate_e)) + ((size_t)(l * 256 + e) * 1024 + 16 * kc) * 256 + c0 + 32 * wcq + rr2;
#define E1Q_LOAD(DST, s_) do { const float* ws_ = wbase_e + (size_t)(128 * ((s_) >> 1) + 8 * ((s_) & 1)) * 256; \
        _Pragma("unroll") for (int j = 0; j < 8; ++j) DST[j] = *(const f32x4*)(ws_ + (size_t)j * 256); asm volatile("" ::: "memory"); } while (0)
#define E1Q_CVT(SRC, hh_) do { _Pragma("unroll") for (int ii = 0; ii < 4; ++ii) { const int n = 4 * bq_ + ii; u32x2 o; \
        int d = __builtin_amdgcn_cvt_pk_fp8_f32(W1Q * SRC[0][ii], W1Q * SRC[1][ii], 0, false); o[0] = (unsigned)__builtin_amdgcn_cvt_pk_fp8_f32(W1Q * SRC[2][ii], W1Q * SRC[3][ii], d, true); \
        d = __builtin_amdgcn_cvt_pk_fp8_f32(W1Q * SRC[4][ii], W1Q * SRC[5][ii], 0, false); o[1] = (unsigned)__builtin_amdgcn_cvt_pk_fp8_f32(W1Q * SRC[6][ii], W1Q * SRC[7][ii], d, true); \
        *(u32x2*)(Bst + n * 128 + ((kc ^ ((n >> 1) & 7)) << 4) + 8 * (hh_)) = o; } } while (0)
#define E1Q_AFILL(kt_) do { _Pragma("unroll") for (int q = 0; q < 4; ++q) { dma16(x1q + ap0[q] + 128u * (kt_), wbase + (((kt_) & 1) * 2) * 16384 + q * 1024); \
        dma16(x1q + ap1[q] + 128u * (kt_), wbase + (((kt_) & 1) * 2 + 1) * 16384 + q * 1024); } asm volatile("" ::: "memory"); } while (0)
#define E1Q_LBAR() do { asm volatile("s_waitcnt lgkmcnt(0)" ::: "memory"); __builtin_amdgcn_s_barrier(); asm volatile("" ::: "memory"); } while (0)
        f32x4 acc0[4][4], acc1[4][4]; zero_acc(acc0); zero_acc(acc1);
        f32x4 wa[8], wb[8];
        __syncthreads();
        E1Q_AFILL(0);
#pragma unroll 1
        for (int kt = 0; kt < 8; ++kt) {
            E1Q_LOAD(wa, 2 * kt); E1Q_LOAD(wb, 2 * kt + 1);
            if (kt + 1 < 8) E1Q_AFILL(kt + 1);
            E1Q_CVT(wa, 0);
            E1Q_CVT(wb, 1);
            E1Q_LBAR();
            {
                i32x8 bf[4];
#pragma unroll
                for (int j = 0; j < 4; ++j) { const i32x4 lo = *(const i32x4*)(Bst + rb0 + j * 2048), hi = *(const i32x4*)(Bst + rb1 + j * 2048); bf[j] = (i32x8){lo[0], lo[1], lo[2], lo[3], hi[0], hi[1], hi[2], hi[3]}; }
                const unsigned char* A0 = smem + ((kt & 1) * 2) * 16384;
#pragma unroll
                for (int i = 0; i < 4; ++i) {
                    const i32x4 lo = *(const i32x4*)(A0 + ra0 + i * 2048), hi = *(const i32x4*)(A0 + ra1 + i * 2048);
                    const i32x8 af = (i32x8){lo[0], lo[1], lo[2], lo[3], hi[0], hi[1], hi[2], hi[3]};
#pragma unroll
                    for (int j = 0; j < 4; ++j) acc0[i][j] = __builtin_amdgcn_mfma_scale_f32_16x16x128_f8f6f4(bf[j], af, acc0[i][j], 0, 0, 0, 0, 0, 0);
                }
                if (has1) {
#pragma unroll
                    for (int i = 0; i < 4; ++i) {
                        const i32x4 lo = *(const i32x4*)(A0 + 16384 + ra0 + i * 2048), hi = *(const i32x4*)(A0 + 16384 + ra1 + i * 2048);
                        const i32x8 af = (i32x8){lo[0], lo[1], lo[2], lo[3], hi[0], hi[1], hi[2], hi[3]};
#pragma unroll
                        for (int j = 0; j < 4; ++j) acc1[i][j] = __builtin_amdgcn_mfma_scale_f32_16x16x128_f8f6f4(bf[j], af, acc1[i][j], 0, 0, 0, 0, 0, 0);
                    }
                }
            }
            E1Q_LBAR();
        }
#undef E1Q_LOAD
#undef E1Q_CVT
#undef E1Q_AFILL
#undef E1Q_LBAR
        const float qs = 1.f / W1Q;
#pragma unroll
        for (int i = 0; i < 4; ++i) {
            const int rr = 64 * _wr + 16 * i + _l15;
            if (rr < nrows) {
                const int a = hrow0 + rr;
                u32x2 hv;
#pragma unroll
                for (int j = 0; j < 2; ++j) { int d = __builtin_amdgcn_cvt_pk_fp8_f32(siluf_(qs * acc0[i][j][0]) * (qs * acc0[i][j + 2][0]), siluf_(qs * acc0[i][j][1]) * (qs * acc0[i][j + 2][1]), 0, false);
                    hv[j] = (unsigned)__builtin_amdgcn_cvt_pk_fp8_f32(siluf_(qs * acc0[i][j][2]) * (qs * acc0[i][j + 2][2]), siluf_(qs * acc0[i][j][3]) * (qs * acc0[i][j + 2][3]), d, true); }
                *(u32x2*)(hq + (size_t)a * 256 + c0 + 32 * _wc + 8 * _kg) = hv;
            }
            if (128 + rr < nrows) {
                const int a = hrow0 + 128 + rr;
                u32x2 hv;
#pragma unroll
                for (int j = 0; j < 2; ++j) { int d = __builtin_amdgcn_cvt_pk_fp8_f32(siluf_(qs * acc1[i][j][0]) * (qs * acc1[i][j + 2][0]), siluf_(qs * acc1[i][j][1]) * (qs * acc1[i][j + 2][1]), 0, false);
                    hv[j] = (unsigned)__builtin_amdgcn_cvt_pk_fp8_f32(siluf_(qs * acc1[i][j][2]) * (qs * acc1[i][j + 2][2]), siluf_(qs * acc1[i][j][3]) * (qs * acc1[i][j + 2][3]), d, true); }
                *(u32x2*)(hq + (size_t)a * 256 + c0 + 32 * _wc + 8 * _kg) = hv;
            }
        }
    }
}

static __device__ __forceinline__ void ph_expert2(CParams& p, int l, unsigned char* smem) {
    EPI_IDX;
    const int G = gridDim.x, vb = vblock();
    const int* ecnt = gptr((const int*)(p.ws + WS_CTL + CTL_ECNT)) + l * 256 * ECS;
    const int* rbase = gptr((const int*)(p.ws + WS_CTL + CTL_RBASE)) + l * 256;
    const int2* rowl = gptr((const int2*)(p.ws + WS_ROWL));
    const unsigned char* hq = gptr((const unsigned char*)(p.ws + WS_HBUF));
    unsigned char* yb = gptr((unsigned char*)(p.ws + WS_YBUF));
    const int sw = (_l15 >> 1) & 7;
    const int ra0 = (_wr * 64 + _l15) * 128 + (((0 + _kg) ^ sw) << 4), ra1 = (_wr * 64 + _l15) * 128 + (((4 + _kg) ^ sw) << 4);
    const int rb0 = (_wc * 64 + _l15) * 128 + (((0 + _kg) ^ sw) << 4), rb1 = (_wc * 64 + _l15) * 128 + (((4 + _kg) ^ sw) << 4);
    const int wid_u = __builtin_amdgcn_readfirstlane(_wid);
    unsigned char* wbase = smem + wid_u * 4096;
    unsigned char* Bst = smem + 49152;
    constexpr float WDQ = 32.f;
    const int bq_ = _t & 31, kc = _t >> 5;
    const int wcol = 64 * (bq_ >> 4) + 16 * (bq_ & 3) + 4 * ((bq_ >> 2) & 3);
    const unsigned junk = (unsigned)(T_ * 8) + (unsigned)vb * 128u + (unsigned)(64 * _wr + _l15);
#define E2S_FILL(rb_, kt_, slot_) do { _Pragma("unroll") for (int q = 0; q < 4; ++q) { const int r_ = (rb_) * 128 + dma_row(_t, q); \
        dma16(hq + (size_t)(hrow0 + (r_ < cnt ? r_ : 0)) * 256 + 128 * (kt_) + 2 * dma_koff(_t, q), wbase + (slot_) * 16384 + q * 1024); } asm volatile("" ::: "memory"); } while (0)
#define E2S_WAITBAR(n_) do { if ((n_) >= 8) asm volatile("s_waitcnt vmcnt(8) lgkmcnt(0)" ::: "memory"); else if ((n_) >= 4) asm volatile("s_waitcnt vmcnt(4) lgkmcnt(0)" ::: "memory"); \
        else asm volatile("s_waitcnt vmcnt(0) lgkmcnt(0)" ::: "memory"); __builtin_amdgcn_s_barrier(); asm volatile("" ::: "memory"); } while (0)
#define E2S_LOADW(DST, s_) do { const float* ws_ = wsrc + (size_t)(128 * ((s_) >> 1) + 8 * ((s_) & 1)) * 1024; \
        _Pragma("unroll") for (int j = 0; j < 8; ++j) DST[j] = *(const f32x4*)(ws_ + (size_t)j * 1024); asm volatile("" ::: "memory"); } while (0)
#define E2S_CVTW(SRC, s_) do { unsigned char* Bk_ = Bst + ((s_) >> 1) * 16384; _Pragma("unroll") for (int ii = 0; ii < 4; ++ii) { const int n = 4 * bq_ + ii; u32x2 o; \
        int d = __builtin_amdgcn_cvt_pk_fp8_f32(WDQ * SRC[0][ii], WDQ * SRC[1][ii], 0, false); o[0] = (unsigned)__builtin_amdgcn_cvt_pk_fp8_f32(WDQ * SRC[2][ii], WDQ * SRC[3][ii], d, true); \
        d = __builtin_amdgcn_cvt_pk_fp8_f32(WDQ * SRC[4][ii], WDQ * SRC[5][ii], 0, false); o[1] = (unsigned)__builtin_amdgcn_cvt_pk_fp8_f32(WDQ * SRC[6][ii], WDQ * SRC[7][ii], d, true); \
        *(u32x2*)(Bk_ + n * 128 + ((kc ^ ((n >> 1) & 7)) << 4) + 8 * ((s_) & 1)) = o; } } while (0)
#define E2S_MFMA(kt_, slot_) do { i32x8 bf_[4]; const unsigned char* Bk_ = Bst + (kt_) * 16384; const unsigned char* A_ = smem + (slot_) * 16384; \
        _Pragma("unroll") for (int j = 0; j < 4; ++j) { const i32x4 lo = *(const i32x4*)(Bk_ + rb0 + j * 2048), hi = *(const i32x4*)(Bk_ + rb1 + j * 2048); bf_[j] = (i32x8){lo[0], lo[1], lo[2], lo[3], hi[0], hi[1], hi[2], hi[3]}; } \
        _Pragma("unroll") for (int i = 0; i < 4; ++i) { const i32x4 lo = *(const i32x4*)(A_ + ra0 + i * 2048), hi = *(const i32x4*)(A_ + ra1 + i * 2048); \
            const i32x8 af_ = (i32x8){lo[0], lo[1], lo[2], lo[3], hi[0], hi[1], hi[2], hi[3]}; \
            _Pragma("unroll") for (int j = 0; j < 4; ++j) acc[i][j] = __builtin_amdgcn_mfma_scale_f32_16x16x128_f8f6f4(bf_[j], af_, acc[i][j], 0, 0, 0, 0, 0, 0); } } while (0)
#define E2S_STORES() do { _Pragma("unroll") for (int i = 0; i < 4; ++i) *(u32x4*)(yb + (size_t)yo[i] * 1024 + n0 + 64 * _wc + 16 * _kg) = dd[i]; asm volatile("" ::: "memory"); } while (0)
    for (int u = vb; u < 256 * 8; u += G) {
        const int e = u >> 3, n0 = (u & 7) * 128;
        const int cnt = __builtin_amdgcn_readfirstlane(ecnt[e * ECS]);
        if (cnt <= 0) continue;
        const int nrb = (cnt + 127) >> 7;
        const int hrow0 = __builtin_amdgcn_readfirstlane(rbase[e]);
        const int2* rl = rowl + (size_t)e * 16384;
        __syncthreads();
        E2S_FILL(0, 0, 0); E2S_FILL(0, 1, 1);
        {
            const float* wsrc = gptr(p.w_down_e) + ((size_t)(l * 256 + e) * 256 + 16 * kc) * 1024 + n0 + wcol;
            f32x4 wa[8], wb[8];
            E2S_LOADW(wa, 0); E2S_LOADW(wb, 1);
            E2S_CVTW(wa, 0); E2S_LOADW(wa, 2);
            E2S_CVTW(wb, 1); E2S_LOADW(wb, 3);
            E2S_CVTW(wa, 2); E2S_CVTW(wb, 3);
        }
        f32x4 acc[4][4]; zero_acc(acc);
        u32x4 dd[4]; unsigned yo[4]; int2 ent[4];
        int slot = 0, ny = 0;
        for (int rb = 0; rb < nrb; ++rb) {
            const bool more = rb + 1 < nrb;
            E2S_WAITBAR(ny); ny = 0;
            if (rb > 0) { E2S_STORES(); ny += 4; }
            { const int s2 = (slot == 0) ? 2 : slot - 1;
              if (more) { E2S_FILL(rb + 1, 0, s2); ny += 4; } }
            E2S_MFMA(0, slot);
            slot = (slot == 2) ? 0 : slot + 1;
            E2S_WAITBAR(ny); ny = 0;
#pragma unroll
            for (int i = 0; i < 4; ++i) { const int rr = rb * 128 + 64 * _wr + 16 * i + _l15; ent[i] = rl[rr < cnt ? rr : 0]; if (rr >= cnt) ent[i].x = (int)(junk + 16u * i); }
            asm volatile("" ::: "memory"); ny += 4;
            { const int s2 = (slot == 0) ? 2 : slot - 1;
              if (more) { E2S_FILL(rb + 1, 1, s2); ny += 4; } }
            E2S_MFMA(1, slot);
            slot = (slot == 2) ? 0 : slot + 1;
#pragma unroll
            for (int i = 0; i < 4; ++i) {
                const float w = (1.f / WDQ) * __int_as_float(ent[i].y);
                yo[i] = (unsigned)ent[i].x;
#pragma unroll
                for (int j = 0; j < 4; ++j) { int d = __builtin_amdgcn_cvt_pk_bf8_f32(w * acc[i][j][0], w * acc[i][j][1], 0, false); dd[i][j] = (unsigned)__builtin_amdgcn_cvt_pk_bf8_f32(w * acc[i][j][2], w * acc[i][j][3], d, true);
                    acc[i][j] = (f32x4){0.f, 0.f, 0.f, 0.f}; }
            }
        }
        E2S_STORES();
    }
#undef E2S_FILL
#undef E2S_WAITBAR
#undef E2S_LOADW
#undef E2S_CVTW
#undef E2S_MFMA
#undef E2S_STORES
}

constexpr int PH_PER_LAYER = 13;
constexpr int N_PHASES = 1 + 2 * PH_PER_LAYER;

__global__ void __launch_bounds__(NTHR, 2) fwd(Params p0) {
    extern __shared__ __attribute__((aligned(16))) unsigned char smem[];
    XcdBarrier bar = xcd_barrier_post((unsigned*)(p0.ws + WS_CTL));
    int ph = 0;
    const int ph_lo = p0.ph_lo, ph_hi = p0.ph_hi;
#ifndef REPEAT_PH
#define REPEAT_PH -1
#endif
#if REPEAT_PH >= 0
#define PHASE_REP(body) if (ph > 0 && ((ph - 1) % PH_PER_LAYER) + 1 == REPEAT_PH) { CParams* pq_ = (CParams*)__builtin_amdgcn_kernarg_segment_ptr(); asm volatile("" : "+s"(pq_)); CParams& p = *pq_; body; xcd_barrier(bar); \
    { const int l_ = (ph - 1) / PH_PER_LAYER; if (blockIdx.x == 0) { int* c_ = gptr((int*)(p.ws + WS_CTL)); if (threadIdx.x == 0) atomicExch(c_ + (CTL_ATTQ + 256 * l_) / 4, 0); \
      if (REPEAT_PH == 10) atomicExch(c_ + CTL_ECNT / 4 + (l_ * 256 + threadIdx.x) * ECS, 0); if (REPEAT_PH == 3) { atomicExch(c_ + CTL_TOT / 4 + (l_ * 512 + threadIdx.x) * TOS, 0); atomicExch(c_ + CTL_TOT / 4 + (l_ * 512 + 256 + threadIdx.x) * TOS, 0); } } } xcd_barrier(bar); }
#else
#define PHASE_REP(body)
#endif
#define PHASE(body) { if (ph >= ph_lo && ph < ph_hi) { PHASE_REP(body) CParams* pp_ = (CParams*)__builtin_amdgcn_kernarg_segment_ptr(); asm volatile("" : "+s"(pp_)); CParams& p = *pp_; body; if (ph + 1 < ph_hi) xcd_barrier(bar); } ++ph; }
    PHASE(ph_prologue(p, smem));
    for (int l = 0; l < 2; ++l) {
        PHASE(ph_inproj(p, l, smem));
        PHASE(ph_kmean_egemm(p, l, smem));
        PHASE(ph_gate_scan(p, l, smem));
        PHASE(ph_attn_ygemm(p, l, smem));
        PHASE(ph_combine_glu(p, l, smem));
        PHASE(ph_merge(p, l, smem));
        PHASE(ph_outproj(p, l, smem));
        PHASE(ph_layernorm<false>(p, gptr((const bf16_t*)(p.ws + WS_Y1)), gptr(p.ln1_g) + l * 1024, gptr(p.ln1_b) + l * 1024, (float*)nullptr, gptr((bf16_t*)(p.ws + WS_X1B)), gptr((unsigned char*)(p.ws + WS_X1Q))));
        PHASE(ph_router_shared1(p, l, smem));
        PHASE(ph_route_shared2(p, l, smem));
        PHASE(ph_expert1(p, l, smem));
        PHASE(ph_expert2(p, l, smem));
        PHASE(ph_layernorm<true>(p, gptr((const bf16_t*)(p.ws + WS_Y1)), gptr(p.ln2_g) + l * 1024, gptr(p.ln2_b) + l * 1024, (l == 1) ? gptr(p.out) : (float*)nullptr, (l == 1) ? (bf16_t*)nullptr : gptr((bf16_t*)(p.ws + WS_XB)), (l == 1) ? (unsigned char*)nullptr : gptr((unsigned char*)(p.ws + WS_XQ))));
    }
#undef PHASE
}

extern "C" void kernel_launch(void* const* d_in, const int* in_sizes, int n_in, void* d_out, int out_size, void* d_ws, size_t ws_size, hipStream_t stream) {
    static int grid = 0;
    if (grid == 0) {
        if (n_in != 28 || out_size != T_ * D_ || ws_size < WS_END) { fprintf(stderr, "kernel_launch: unexpected sizes n_in %d out %d ws %zu (need %zu)\n", n_in, out_size, ws_size, (size_t)WS_END); grid = -1; return; }
        int dev = 0, cus = 0, per_cu = 0;
        hipGetDevice(&dev); hipDeviceGetAttribute(&cus, hipDeviceAttributeMultiprocessorCount, dev);
        hipFuncSetAttribute((const void*)fwd, hipFuncAttributeMaxDynamicSharedMemorySize, LDS_BYTES);
        hipOccupancyMaxActiveBlocksPerMultiprocessor(&per_cu, (const void*)fwd, NTHR, LDS_BYTES);
        (void)hipGetLastError();
        if (per_cu < 1) per_cu = 1;
        grid = cus * (per_cu < 2 ? per_cu : 2);
        fprintf(stderr, "kernel_launch: cus %d per_cu %d grid %d\n", cus, per_cu, grid);
    }
    if (grid < 0) return;
    hipMemsetAsync((char*)d_ws + WS_CTL, 0, CTL_BYTES, stream);
    Params p{};
    p.x = (const float*)d_in[0]; p.positions = (const int*)d_in[1]; p.w_in = (const float*)d_in[2]; p.attn_up = (const float*)d_in[3];
    p.lam_re = (const float*)d_in[4]; p.lam_im = (const float*)d_in[5]; p.log_dt = (const float*)d_in[6]; p.b_re = (const float*)d_in[7]; p.b_im = (const float*)d_in[8];
    p.c_re = (const float*)d_in[9]; p.c_im = (const float*)d_in[10]; p.d_skip = (const float*)d_in[11]; p.w_glu = (const float*)d_in[12]; p.b_glu = (const float*)d_in[13];
    p.s5_up = (const float*)d_in[14]; p.w_o = (const float*)d_in[15]; p.ln1_g = (const float*)d_in[16]; p.ln1_b = (const float*)d_in[17];
    p.w_router = (const float*)d_in[18]; p.router_bias = (const float*)d_in[19]; p.w_gate_e = (const float*)d_in[20]; p.w_up_e = (const float*)d_in[21]; p.w_down_e = (const float*)d_in[22];
    p.ws_gate = (const float*)d_in[23]; p.ws_up = (const float*)d_in[24]; p.ws_down = (const float*)d_in[25]; p.ln2_g = (const float*)d_in[26]; p.ln2_b = (const float*)d_in[27];
    p.out = (float*)d_out; p.ws = (unsigned char*)d_ws;
#if N_LAUNCH_MODE == 1
    p.ph_lo = 0; p.ph_hi = N_PHASES;
    hipLaunchKernelGGL(fwd, dim3(grid), dim3(NTHR), LDS_BYTES, stream, p);
#else
    for (int ph = 0; ph < N_PHASES; ++ph) { p.ph_lo = ph; p.ph_hi = ph + 1; hipLaunchKernelGGL(fwd, dim3(grid), dim3(NTHR), LDS_BYTES, stream, p); }
#endif
}
```
